# Optimizing an MI355X kernel written in HIP

```python
import math
import jax, jax.numpy as jnp
from jax import lax
import numpy as np

D_MODEL = 1024
BATCH = 32
SEQ = 2048
DEPTH = 1

MEM_LEN = 256
CHUNK = 128
RET_HEADS = 4
RET_DK = 64
RET_DV = 128
ML_HEADS = 4
ML_DK = 128
ML_DV = 128
CONV_W = 4
XA_HEADS = 4
XA_DH = D_MODEL // XA_HEADS
N_GROUPS = 4
EXP_PER_GROUP = 8
N_EXPERTS = N_GROUPS * EXP_PER_GROUP
TOP_K = 2
D_EXPERT = 512
MOE_BLOCK = 128
ROPE_BASE = 10000.0
EPS = 1e-6

RET_QK = RET_HEADS * RET_DK
RET_V = RET_HEADS * RET_DV
ML_QK = ML_HEADS * ML_DK
ML_V = ML_HEADS * ML_DV
MIX_WIDTH = RET_V + ML_V
SPLITS = (RET_QK, RET_QK, RET_V, RET_V, 2 * ML_QK, ML_V, ML_V, 2 * ML_HEADS)
IN_WIDTH = sum(SPLITS)

kernel_name = "hymba_retnet_mlstm_xattn_hmoe"


def rmsnorm(x, w):
    xf = x.astype(jnp.float32)
    y = xf * lax.rsqrt(jnp.mean(xf * xf, axis=-1, keepdims=True) + EPS)
    return (y * w.astype(jnp.float32)).astype(x.dtype)


def head_norm(h, w):
    mu = jnp.mean(h, axis=-1, keepdims=True)
    var = jnp.mean(jnp.square(h - mu), axis=-1, keepdims=True)
    y = (h - mu) * lax.rsqrt(var + EPS)
    B, S, H, d = h.shape
    return y.reshape(B, S, H * d) * w.astype(jnp.float32)


def rope(x, pos):
    half = x.shape[-1] // 2
    inv = ROPE_BASE ** (-jnp.arange(half, dtype=jnp.float32) / half)
    ang = pos.astype(jnp.float32)[:, None] * inv[None, :]
    cos = jnp.cos(ang)[None, :, None, :]
    sin = jnp.sin(ang)[None, :, None, :]
    x1, x2 = x[..., :half], x[..., half:]
    return jnp.concatenate([x1 * cos - x2 * sin, x1 * sin + x2 * cos], axis=-1)


def causal_conv(x, w, b):
    C = x.shape[-1]
    y = lax.conv_general_dilated(x, w[:, None, :].astype(x.dtype), window_strides=(1,),
                                 padding=[(CONV_W - 1, 0)],
                                 dimension_numbers=("NWC", "WIO", "NWC"),
                                 feature_group_count=C)
    return y + b.astype(x.dtype)


def retention(q, k, v):
    B, S, H, dk = q.shape
    dv = v.shape[-1]
    L = CHUNK
    nc = S // L
    log_g = jnp.log1p(-jnp.exp2(-5.0 - jnp.arange(H, dtype=jnp.float32)))
    q = q.reshape(B, nc, L, H, dk)
    k = k.reshape(B, nc, L, H, dk)
    v = v.reshape(B, nc, L, H, dv)
    n = jnp.arange(L, dtype=jnp.float32)
    diff = n[:, None] - n[None, :]
    dmat = jnp.where(diff >= 0, jnp.exp(log_g[:, None, None] * jnp.maximum(diff, 0.0)[None]), 0.0)
    scores = jnp.einsum('bclhd,bcmhd->bchlm', q, k) * dmat
    inner = jnp.einsum('bchlm,bcmhe->bclhe', scores, v)
    k_dec = k * jnp.exp((L - 1 - n)[:, None] * log_g[None, :])[:, :, None]
    kv = jnp.einsum('bclhd,bclhe->cbhde', k_dec, v)
    chunk_decay = jnp.exp(L * log_g)[None, :, None, None]

    def step(R, kv_c):
        return chunk_decay * R + kv_c, R

    _, R_prev = lax.scan(step, jnp.zeros((B, H, dk, dv), jnp.float32), kv)
    q_dec = q * jnp.exp((n + 1)[:, None] * log_g[None, :])[:, :, None]
    cross = jnp.einsum('bclhd,cbhde->bclhe', q_dec, R_prev)
    return (inner + cross).reshape(B, S, H, dv)


def mlstm(q, k, v, i_pre, f_pre):
    B, S, H, dk = q.shape
    dv = v.shape[-1]
    L = CHUNK
    nc = S // L

    def chunked(t):
        return t.reshape(B, nc, L, H, -1).transpose(0, 1, 3, 2, 4)

    q = chunked(q)
    k = chunked(k) * (dk ** -0.5)
    v = chunked(v)
    logf = jax.nn.log_sigmoid(f_pre).reshape(B, nc, L, H).transpose(0, 1, 3, 2)
    ig = i_pre.reshape(B, nc, L, H).transpose(0, 1, 3, 2)
    b = jnp.cumsum(logf, axis=-1)
    b_tot = b[..., -1]
    causal = jnp.tril(jnp.ones((L, L), bool))
    logD = jnp.where(causal, b[..., :, None] - b[..., None, :] + ig[..., None, :], -jnp.inf)
    m_intra = jnp.max(logD, axis=-1)
    a = b_tot[..., None] - b + ig
    m_loc = jnp.max(a, axis=-1)
    wa = jnp.exp(a - m_loc[..., None])
    kw = k * wa[..., None]
    kv_loc = jnp.einsum('bchld,bchle->cbhde', kw, v)
    n_loc = jnp.moveaxis(jnp.sum(kw, axis=3), 1, 0)

    def step(carry, inp):
        C, nvec, m = carry
        g, ml, kvc, nlc = inp
        m_new = jnp.maximum(g + m, ml)
        s_old = jnp.exp(g + m - m_new)
        s_loc = jnp.exp(ml - m_new)
        C_new = s_old[..., None, None] * C + s_loc[..., None, None] * kvc
        n_new = s_old[..., None] * nvec + s_loc[..., None] * nlc
        return (C_new, n_new, m_new), (C, nvec, m)

    init = (jnp.zeros((B, H, dk, dv), jnp.float32), jnp.zeros((B, H, dk), jnp.float32),
            jnp.zeros((B, H), jnp.float32))
    _, (C_prev, n_prev, m_prev) = lax.scan(
        step, init, (jnp.moveaxis(b_tot, 1, 0), jnp.moveaxis(m_loc, 1, 0), kv_loc, n_loc))
    m_prev = jnp.moveaxis(m_prev, 0, 1)
    m_inter = b + m_prev[..., None]
    m_t = jnp.maximum(m_intra, m_inter)
    s = jnp.einsum('bchtd,bchsd->bchts', q, k) * jnp.exp(logD - m_t[..., None])
    inter = jnp.exp(m_inter - m_t)
    num = jnp.einsum('bchts,bchse->bchte', s, v) + inter[..., None] * jnp.einsum('bchtd,cbhde->bchte', q, C_prev)
    den = jnp.sum(s, axis=-1) + inter * jnp.einsum('bchtd,cbhd->bcht', q, n_prev)
    h = num / jnp.maximum(jnp.abs(den), jnp.exp(-m_t))[..., None]
    return h.transpose(0, 1, 3, 2, 4).reshape(B, S, H, dv)


def hybrid_mixer(h, w_in, ret_norm_w, ml_conv_w, ml_conv_b, ml_gate_b, ml_norm_w, w_out):
    B, S, _ = h.shape
    proj = h @ w_in
    r_q, r_k, r_v, r_g, m_qk, m_v, m_o, m_if = jnp.split(proj, [int(c) for c in np.cumsum(SPLITS)[:-1]], axis=-1)
    pos = jnp.arange(S)
    rq = rope(r_q.reshape(B, S, RET_HEADS, RET_DK).astype(jnp.float32), pos)
    rk = rope(r_k.reshape(B, S, RET_HEADS, RET_DK).astype(jnp.float32), pos) * (RET_DK ** -0.5)
    rv = r_v.reshape(B, S, RET_HEADS, RET_DV).astype(jnp.float32)
    ret = head_norm(retention(rq, rk, rv), ret_norm_w) * jax.nn.silu(r_g.astype(jnp.float32))
    qk = jax.nn.silu(causal_conv(m_qk, ml_conv_w, ml_conv_b)).astype(jnp.float32)
    mq = qk[..., :ML_QK].reshape(B, S, ML_HEADS, ML_DK)
    mk = qk[..., ML_QK:].reshape(B, S, ML_HEADS, ML_DK)
    mv = m_v.reshape(B, S, ML_HEADS, ML_DV).astype(jnp.float32)
    gates = m_if.astype(jnp.float32) + ml_gate_b.astype(jnp.float32)
    hm = mlstm(mq, mk, mv, gates[..., :ML_HEADS], gates[..., ML_HEADS:])
    ml = jax.nn.sigmoid(m_o.astype(jnp.float32)) * head_norm(hm, ml_norm_w)
    return jnp.concatenate([ret, ml], axis=-1).astype(h.dtype) @ w_out


def mem_cross_attention(h, mem_n, wq, wkv, wo):
    B, S, D = h.shape
    M = mem_n.shape[1]
    q = (h @ wq).reshape(B, S, XA_HEADS, XA_DH)
    kv = mem_n @ wkv
    k = kv[..., :D].reshape(B, M, XA_HEADS, XA_DH)
    v = kv[..., D:].reshape(B, M, XA_HEADS, XA_DH)
    logits = jnp.einsum('bshd,bmhd->bhsm', q, k).astype(jnp.float32) * (XA_DH ** -0.5)
    p = jax.nn.softmax(logits, axis=-1).astype(h.dtype)
    o = jnp.einsum('bhsm,bmhd->bshd', p, v).reshape(B, S, D)
    return o @ wo


def hier_moe(h, w_group, b_group, w_router, b_router, w_gate, w_up, w_down):
    B, S, D = h.shape
    N = B * S
    xt = h.reshape(N, D)
    xf = xt.astype(jnp.float32)
    g_logits = xf @ w_group.astype(jnp.float32) + b_group.astype(jnp.float32)
    g_prob = jax.nn.softmax(g_logits, axis=-1)
    g_sel = jnp.argmax(g_logits, axis=-1)
    g_w = jnp.take_along_axis(g_prob, g_sel[:, None], axis=-1)[:, 0]
    e_logits = (xf @ w_router.astype(jnp.float32) + b_router.astype(jnp.float32)).reshape(N, N_GROUPS, EXP_PER_GROUP)
    e_logits = jnp.take_along_axis(e_logits, g_sel[:, None, None], axis=1)[:, 0]
    e_prob = jax.nn.softmax(e_logits, axis=-1)
    top_p, top_i = lax.top_k(e_prob, TOP_K)
    top_p = top_p / jnp.sum(top_p, axis=-1, keepdims=True)
    weights = g_w[:, None] * top_p
    expert = g_sel[:, None] * EXP_PER_GROUP + top_i
    NK = N * TOP_K
    flat_e = expert.reshape(NK).astype(jnp.int32)
    flat_tok = jnp.repeat(jnp.arange(N, dtype=jnp.int32), TOP_K)
    order = jnp.argsort(flat_e)
    sorted_e = flat_e[order]
    counts = jnp.zeros((N_EXPERTS,), jnp.int32).at[flat_e].add(1)
    starts = jnp.cumsum(counts) - counts
    padded = (counts + MOE_BLOCK - 1) // MOE_BLOCK * MOE_BLOCK
    pstarts = jnp.cumsum(padded) - padded
    pends = pstarts + padded
    dest_sorted = pstarts[sorted_e] + (jnp.arange(NK, dtype=jnp.int32) - starts[sorted_e])
    cap = NK + N_EXPERTS * MOE_BLOCK
    nblk = cap // MOE_BLOCK
    row_tok = jnp.full((cap,), N, jnp.int32).at[dest_sorted].set(flat_tok[order])
    blk_start = jnp.arange(nblk, dtype=jnp.int32) * MOE_BLOCK
    blk_e = jnp.minimum(jnp.sum(blk_start[:, None] >= pends[None, :], axis=1), N_EXPERTS - 1).astype(jnp.int32)
    x_pad = jnp.concatenate([xt, jnp.zeros((1, D), xt.dtype)], axis=0)
    xs = x_pad[row_tok].reshape(nblk, MOE_BLOCK, D)

    def expert_block(args):
        xb, e = args
        hid = jax.nn.silu(xb @ w_gate[e]) * (xb @ w_up[e])
        return hid @ w_down[e]

    ys = lax.map(expert_block, (xs, blk_e)).reshape(cap, D)
    dest = jnp.zeros((NK,), jnp.int32).at[order].set(dest_sorted)
    y = ys[dest].reshape(N, TOP_K, D)
    y = jnp.sum(y * weights[..., None].astype(y.dtype), axis=1)
    return y.reshape(B, S, D)


def setup_inputs(seed: int = 0) -> dict:
    key = jax.random.key(seed)
    ks = jax.random.split(key, 24)
    f32 = jnp.float32

    def nrm(k, shape, scale):
        return jax.random.normal(k, shape, f32) * scale

    def gain(k, shape):
        return 1.0 + 0.05 * jax.random.normal(k, shape, f32)

    Dp = DEPTH
    i_bias = 0.1 * jax.random.normal(ks[6], (Dp, ML_HEADS), f32)
    f_bias = jnp.linspace(3.0, 6.0, ML_HEADS, dtype=f32)[None] + 0.1 * jax.random.normal(ks[7], (Dp, ML_HEADS), f32)
    return {
        "x": jax.random.normal(ks[0], (BATCH, SEQ, D_MODEL), f32),
        "mem": jax.random.normal(ks[1], (BATCH, MEM_LEN, D_MODEL), f32),
        "norm_mix_w": gain(ks[2], (Dp, D_MODEL)),
        "w_in": nrm(ks[3], (Dp, D_MODEL, IN_WIDTH), D_MODEL ** -0.5),
        "ret_norm_w": gain(ks[4], (Dp, RET_V)),
        "ml_conv_w": nrm(ks[5], (Dp, CONV_W, 2 * ML_QK), CONV_W ** -0.5),
        "ml_conv_b": nrm(ks[8], (Dp, 2 * ML_QK), 0.01),
        "ml_gate_b": jnp.concatenate([i_bias, f_bias], axis=-1),
        "ml_norm_w": gain(ks[9], (Dp, ML_V)),
        "w_out": nrm(ks[10], (Dp, MIX_WIDTH, D_MODEL), MIX_WIDTH ** -0.5),
        "norm_xa_w": gain(ks[11], (Dp, D_MODEL)),
        "norm_mem_w": gain(ks[12], (Dp, D_MODEL)),
        "xa_wq": nrm(ks[13], (Dp, D_MODEL, D_MODEL), D_MODEL ** -0.5),
        "xa_wkv": nrm(ks[14], (Dp, D_MODEL, 2 * D_MODEL), D_MODEL ** -0.5),
        "xa_wo": nrm(ks[15], (Dp, D_MODEL, D_MODEL), D_MODEL ** -0.5),
        "norm_moe_w": gain(ks[16], (Dp, D_MODEL)),
        "moe_w_group": nrm(ks[17], (Dp, D_MODEL, N_GROUPS), D_MODEL ** -0.5),
        "moe_b_group": nrm(ks[18], (Dp, N_GROUPS), 0.01),
        "moe_w_router": nrm(ks[19], (Dp, D_MODEL, N_EXPERTS), D_MODEL ** -0.5),
        "moe_b_router": nrm(ks[20], (Dp, N_EXPERTS), 0.01),
        "moe_w_gate": nrm(ks[21], (Dp, N_EXPERTS, D_MODEL, D_EXPERT), D_MODEL ** -0.5),
        "moe_w_up": nrm(ks[22], (Dp, N_EXPERTS, D_MODEL, D_EXPERT), D_MODEL ** -0.5),
        "moe_w_down": nrm(ks[23], (Dp, N_EXPERTS, D_EXPERT, D_MODEL), D_EXPERT ** -0.5),
        "norm_final_w": gain(jax.random.fold_in(key, 99), (D_MODEL,)),
    }


def reference(x, mem, norm_mix_w, w_in, ret_norm_w, ml_conv_w, ml_conv_b, ml_gate_b, ml_norm_w, w_out,
              norm_xa_w, norm_mem_w, xa_wq, xa_wkv, xa_wo, norm_moe_w, moe_w_group, moe_b_group,
              moe_w_router, moe_b_router, moe_w_gate, moe_w_up, moe_w_down, norm_final_w):
    for l in range(DEPTH):
        h = rmsnorm(x, norm_mix_w[l])
        x = x + hybrid_mixer(h, w_in[l], ret_norm_w[l], ml_conv_w[l], ml_conv_b[l], ml_gate_b[l],
                             ml_norm_w[l], w_out[l])
        h = rmsnorm(x, norm_xa_w[l])
        x = x + mem_cross_attention(h, rmsnorm(mem, norm_mem_w[l]), xa_wq[l], xa_wkv[l], xa_wo[l])
        h = rmsnorm(x, norm_moe_w[l])
        x = x + hier_moe(h, moe_w_group[l], moe_b_group[l], moe_w_router[l], moe_b_router[l],
                         moe_w_gate[l], moe_w_up[l], moe_w_down[l])
    return rmsnorm(x, norm_final_w)
```

```cpp
#include <hip/hip_runtime.h>
#include <hip/hip_cooperative_groups.h>
#include <cstdio>
#include <cstdint>
namespace cg = cooperative_groups;
#ifndef DUPK
#define DUPK (-1)
#endif
#ifndef DBGV
#define DBGV 0
#endif

#define DI __device__ __forceinline__
#define LAS __attribute__((address_space(3)))
typedef unsigned short bf16_t;
typedef short bf16x8 __attribute__((ext_vector_type(8)));
typedef short s16x4 __attribute__((ext_vector_type(4)));
typedef float f32x4 __attribute__((ext_vector_type(4)));
typedef float f32x2 __attribute__((ext_vector_type(2)));
typedef unsigned u32x4 __attribute__((ext_vector_type(4)));
typedef unsigned u32x2 __attribute__((ext_vector_type(2)));
typedef __bf16 bf16x2_t __attribute__((ext_vector_type(2)));
typedef LAS unsigned char* lptr;

constexpr int NT = 65536, DM = 1024, SEQ = 2048, NB = 32;
constexpr int INW = 3592, NP1 = 3584;
constexpr int MEMT = 8192;
constexpr int NEXP = 32, DEXP = 512;
constexpr int CAPE = 131072;
constexpr float EPS = 1e-6f;
constexpr int NWAVES = 8, NTHR = 512;

constexpr size_t MiB = 1u << 20;
constexpr size_t WS_CTL = 0, CTL_ZERO_BYTES = 64 * 1024;
constexpr size_t WS_WIN  = 1 * MiB;
constexpr size_t WS_WOUT = 8 * MiB;
constexpr size_t WS_WQ   = 10 * MiB;
constexpr size_t WS_WKV  = 12 * MiB;
constexpr size_t WS_WO   = 16 * MiB;
constexpr size_t WS_W1   = 18 * MiB;
constexpr size_t WS_W2   = 82 * MiB;
constexpr size_t WS_WR   = 114 * MiB;
constexpr size_t WS_ROPE = 115 * MiB;
constexpr size_t WS_GATES = 116 * MiB;
constexpr size_t WS_SSQ1 = 118 * MiB;
constexpr size_t WS_ROWID = 122 * MiB;
constexpr size_t WS_ROWF = 138 * MiB;
constexpr size_t WS_MEMN = 170 * MiB;
constexpr size_t WS_KV   = 186 * MiB;
constexpr size_t WS_A    = 218 * MiB;
constexpr size_t WS_B    = 346 * MiB;
constexpr size_t WS_C    = 794 * MiB;
constexpr size_t WS_XN0 = WS_A, WS_X1B = WS_A;
constexpr size_t WS_PROJ = WS_B, WS_Q = WS_B, WS_O = WS_B + 128 * MiB, WS_X2B = WS_B + 256 * MiB, WS_YBUF = WS_B;
constexpr size_t WS_MIX = WS_C, WS_HID = WS_C;
constexpr size_t WS_X1Q8 = WS_B + 128 * MiB;
constexpr size_t WS_XQ8 = WS_B + 384 * MiB;
constexpr size_t WS_GARR = 930 * MiB;
constexpr size_t WS_RMS = 934 * MiB;
constexpr size_t WS_END = 935 * MiB;
constexpr int CW_CNT = 64;
constexpr int CW_BAR = 4096;

constexpr int LDS_BYTES = 163840;
constexpr int MISC_OFF = 162816;

DI int lane_id() { return (int)__builtin_amdgcn_mbcnt_hi(~0u, __builtin_amdgcn_mbcnt_lo(~0u, 0u)); }
DI int lane_id_v() { int l; asm volatile("v_mbcnt_lo_u32_b32 %0, -1, 0\n\tv_mbcnt_hi_u32_b32 %0, -1, %0" : "=v"(l)); return l; }
DI float bf2f(unsigned short u) { return __uint_as_float((unsigned)u << 16); }
DI float bflo(unsigned u) { return __uint_as_float(u << 16); }
DI float bfhi(unsigned u) { return __uint_as_float(u & 0xffff0000u); }
DI unsigned pk2(float lo, float hi) { f32x2 v = {lo, hi}; bf16x2_t b = __builtin_convertvector(v, bf16x2_t); return __builtin_bit_cast(unsigned, b); }
DI float wave_sum(float v) {
#pragma unroll
    for (int o = 1; o < 64; o <<= 1) v += __shfl_xor(v, o);
    return v;
}
DI f32x4 mfma16(bf16x8 a, bf16x8 b, f32x4 c) { return __builtin_amdgcn_mfma_f32_16x16x32_bf16(a, b, c, 0, 0, 0); }
DI bf16x8 lds16(lptr p) { return *(const LAS bf16x8*)p; }
DI s16x4 ldstr(lptr p) { return __builtin_bit_cast(s16x4, __builtin_amdgcn_ds_read_tr16_b64_v4i16((LAS s16x4*)p)); }
DI bf16x8 cat4(s16x4 a, s16x4 b) { return (bf16x8){a[0], a[1], a[2], a[3], b[0], b[1], b[2], b[3]}; }
#define SCHED_FENCE() __builtin_amdgcn_sched_barrier(0)
DI float clamp448(float v) { return fminf(fmaxf(v, -448.f), 448.f); }
DI unsigned pk4_fp8(float a, float b, float c, float d) {
    int w = 0; w = __builtin_amdgcn_cvt_pk_fp8_f32(clamp448(a), clamp448(b), w, false); w = __builtin_amdgcn_cvt_pk_fp8_f32(clamp448(c), clamp448(d), w, true); return (unsigned)w; }
DI float silu_f(float x) { return x * __builtin_amdgcn_rcpf(1.f + __expf(-x)); }
DI float sigm_f(float x) { return __builtin_amdgcn_rcpf(1.f + __expf(-x)); }

namespace pg8 {
constexpr int BM = 256, BK = 64, HALF = 128, HTB = HALF * BK * 2, STAGE_BYTES = 8 * HTB, NXCD = 8, WGM = 8;
__host__ __device__ __forceinline__ int lds_byte(int r, int c) { const int st = (r >> 4) * 2 + (c >> 5), rr = r & 15, cc = c & 31, ob = rr * 64 + cc * 2; return st * 1024 + (ob ^ (((ob >> 9) & 1) << 5)); }
__host__ __device__ __forceinline__ void stage_rc(int b, int& R, int& C) { const int st = b / 1024, sb = b % 1024, swz = sb ^ (((sb >> 9) & 1) << 5); R = (st >> 1) * 16 + swz / 64; C = (st & 1) * 32 + (swz % 64) / 2; }
__host__ __device__ __forceinline__ int perm32(int rho) { const int n = rho >> 4, i = rho & 15; return 8 * (i >> 2) + 4 * n + (i & 3); }

struct Unit { const char* A; const char* B; int pm, pn, tag, aux; };

struct DenseOrder {
    int nM, nN, nwg, G, c;
    DI void init(int M, int N, int G_, int c_) { nM = M / BM; nN = N / BM; nwg = nM * nN; G = G_; c = c_; }
    DI bool tile(int i, int& pm, int& pn) const {
        const long L = (long)i * G + c; if (L >= nwg) return false;
        int wgid = (int)L; { const int q = nwg / NXCD, r = nwg % NXCD, xcd = wgid % NXCD, off = wgid / NXCD; wgid = (xcd < r ? xcd * (q + 1) : r * (q + 1) + (xcd - r) * q) + off; }
        const int nig = WGM * nN, gid = wgid / nig, fm = gid * WGM, gsz = (nM - fm) < WGM ? (nM - fm) : WGM;
        pm = fm + ((wgid % nig) % gsz); pn = (wgid % nig) / gsz; return true;
    }
};

typedef int v8i32 __attribute__((ext_vector_type(8)));
template <class Epi, class Sched, bool GATHER, bool FP8 = false>
DI void gemm_phase(lptr lds, const int pitch  , const Sched& S, const Epi& E, const int wid, const int scale_w = 127, const int scale_x = 127) {
    const int K = pitch >> 1;
    const int lane = lane_id(), tid = wid * 64 + lane, wr = wid >> 2, wc = wid & 3, fr = lane & 15, fq = lane >> 4;
    const int nt = pitch / (BK * 2);
    unsigned vA[2][2], nvA[2][2], voffB[2];
#pragma unroll
    for (int i = 0; i < 2; ++i) { int R, C; stage_rc(tid * 16 + i * 8192, R, C); const int Rb = (R & ~31) + perm32(R & 31);
        vA[0][i] = (unsigned)(R * K + C) * 2u; vA[1][i] = (unsigned)((R + HALF) * K + C) * 2u; voffB[i] = (unsigned)(Rb * K + C) * 2u;
        nvA[0][i] = vA[0][i]; nvA[1][i] = vA[1][i]; }
    const size_t kstep = (size_t)(BK * 2);
    const size_t hstep = (size_t)HALF * K * 2;
    const unsigned ldsw = (unsigned)wid * 1024u;
    const int aoff = FP8 ? lds_byte(wr * 64 + fr, fq * 16) : lds_byte(wr * 64 + fr, fq * 8), boff = FP8 ? lds_byte(wc * 32 + fr, fq * 16) : lds_byte(wc * 32 + fr, fq * 8);
#define PG8_SA(b, h) (((b) * 2 + (h)) * HTB)
#define PG8_SB(b, h) ((4 + (b) * 2 + (h)) * HTB)
#define PG8_STAGE(bufoff, gbase, voff) do { _Pragma("unroll") for (int _i = 0; _i < 2; ++_i) \
        __builtin_amdgcn_global_load_lds((const unsigned*)((const char*)(gbase) + (voff)[_i]), (LAS unsigned*)(lds + (bufoff) + ldsw + _i * 8192), 16, 0, 0); } while (0)
#define PG8_LD8(p_) __builtin_shufflevector(*(const LAS u32x4*)(p_), *(const LAS u32x4*)((p_) + 16), 0, 1, 2, 3, 4, 5, 6, 7)
#define PG8_LDA(dst, b, h) do { if constexpr (FP8) { _Pragma("unroll") for (int m = 0; m < 4; ++m) dst##8[m] = PG8_LD8(lds + PG8_SA(b, h) + aoff + m * 2048); } \
        else { _Pragma("unroll") for (int m = 0; m < 4; ++m) _Pragma("unroll") for (int k = 0; k < 2; ++k) dst[m][k] = *(const LAS bf16x8*)(lds + PG8_SA(b, h) + aoff + m * 2048 + k * 1024); } } while (0)
#define PG8_LDB(dst, b, h) do { if constexpr (FP8) { _Pragma("unroll") for (int n = 0; n < 2; ++n) dst##8[n] = PG8_LD8(lds + PG8_SB(b, h) + boff + n * 2048); } \
        else { _Pragma("unroll") for (int n = 0; n < 2; ++n) _Pragma("unroll") for (int k = 0; k < 2; ++k) dst[n][k] = *(const LAS bf16x8*)(lds + PG8_SB(b, h) + boff + n * 2048 + k * 1024); } } while (0)
#define PG8_MMA(ai, bj, At, Bt) do { __builtin_amdgcn_s_setprio(1); _Pragma("unroll") for (int m = 0; m < 4; ++m) _Pragma("unroll") for (int n = 0; n < 2; ++n) { \
        if constexpr (FP8) asm volatile("v_mfma_scale_f32_16x16x128_f8f6f4 %0, %1, %2, %0, %3, %4 op_sel_hi:[0,0,0]" : "+v"(acc[ai][bj][m][n]) : "v"(Bt##8[n]), "v"(At##8[m]), "v"(scw_), "v"(sca_));   \
        else { _Pragma("unroll") for (int k = 0; k < 2; ++k) acc[ai][bj][m][n] = __builtin_amdgcn_mfma_f32_16x16x32_bf16(Bt[n][k], At[m][k], acc[ai][bj][m][n], 0, 0, 0); } } \
        __builtin_amdgcn_s_setprio(0); } while (0)
#define PG8_WAIT_V(n) asm volatile("s_waitcnt vmcnt(" #n ")" ::: "memory")
#define PG8_WAIT_L(n) asm volatile("s_waitcnt lgkmcnt(" #n ")" ::: "memory")
#define PG8_BAR __builtin_amdgcn_s_barrier()
#define PG8_SCHED __builtin_amdgcn_sched_barrier(0)
    Unit cur, nxt; int ui = 0;
    if (!S.next(0, cur)) return;
    if constexpr (GATHER) {
        int t2 = tid; asm volatile("" : "+v"(t2));
        unsigned rid0[2][2]; const int left0 = S.rows_left(cur);
#pragma unroll
        for (int i = 0; i < 2; ++i) { int R, C; stage_rc(t2 * 16 + i * 8192, R, C);
#pragma unroll
            for (int h = 0; h < 2; ++h) asm volatile("global_load_dword %0, %1, off" : "=v"(rid0[h][i]) : "v"(S.arow_ptr(cur, h * HALF + R)) : "memory"); }
        asm volatile("s_waitcnt vmcnt(0)" : "+v"(rid0[0][0]), "+v"(rid0[0][1]), "+v"(rid0[1][0]), "+v"(rid0[1][1]) :: "memory");
#pragma unroll
        for (int i = 0; i < 2; ++i) { int R, C; stage_rc(t2 * 16 + i * 8192, R, C);
#pragma unroll
            for (int h = 0; h < 2; ++h) vA[h][i] = ((h * HALF + R) < left0 ? (rid0[h][i] >> 1) : 0u) * (unsigned)(K * 2) + (unsigned)C * 2u; }
    }
    f32x4 acc[2][2][4][2];
#pragma unroll
    for (int a = 0; a < 2; ++a)
#pragma unroll
        for (int b = 0; b < 2; ++b)
#pragma unroll
            for (int m = 0; m < 4; ++m)
#pragma unroll
                for (int n = 0; n < 2; ++n) acc[a][b][m][n] = (f32x4){0.f, 0.f, 0.f, 0.f};
    bf16x8 At[4][2], B0[2][2], B1[2][2];
    typedef unsigned u32x8 __attribute__((ext_vector_type(8)));
    u32x8 At8[4], B08[2], B18[2];
    const int scw_ = scale_w, sca_ = scale_x;
    const char* cA = cur.A; const char* cB = cur.B;
    PG8_STAGE(PG8_SB(0, 0), cB, voffB); PG8_STAGE(PG8_SB(0, 1), cB + hstep, voffB); PG8_STAGE(PG8_SA(0, 0), cA, vA[0]); PG8_STAGE(PG8_SA(0, 1), cA, vA[1]);
    if (wr == 1) PG8_BAR;
    PG8_WAIT_V(2); PG8_BAR;
    PG8_STAGE(PG8_SB(1, 0), cB + kstep, voffB); PG8_STAGE(PG8_SA(1, 0), cA + kstep, vA[0]); PG8_STAGE(PG8_SB(1, 1), cB + hstep + kstep, voffB);
    PG8_WAIT_V(6); PG8_BAR;
    unsigned pre[Epi::NPRE > 0 ? Epi::NPRE : 1];
    for (;;) {
        const bool has_next = S.next(ui + 1, nxt);
        if constexpr (Epi::NPRE > 0) E.prefetch(pre, cur, wr, fr);
        const char* nA = has_next ? nxt.A : cA; const char* nB = has_next ? nxt.B : cB;
        unsigned nrid[2][2]; int nleft = 0;
        if constexpr (GATHER) {
            int t2 = tid; asm volatile("" : "+v"(t2));
            if (has_next) { nleft = S.rows_left(nxt);
#pragma unroll
                for (int i = 0; i < 2; ++i) { int R, C; stage_rc(t2 * 16 + i * 8192, R, C);
#pragma unroll
                    for (int h = 0; h < 2; ++h) asm volatile("global_load_dword %0, %1, off" : "=v"(nrid[h][i]) : "v"(S.arow_ptr(nxt, h * HALF + R)) : "memory"); }
            } else {
#pragma unroll
                for (int i = 0; i < 2; ++i)
#pragma unroll
                    for (int h = 0; h < 2; ++h) { nvA[h][i] = vA[h][i]; nrid[h][i] = 0u; }
            }
        }
#pragma unroll 1
        for (int t = 0; t < nt; t += 2) {
            const bool last = (t == nt - 2);
            const char* a1 = cA + (size_t)(t + 1) * kstep;
            const char* a2 = last ? nA : cA + (size_t)(t + 2) * kstep; const char* b2 = last ? nB : cB + (size_t)(t + 2) * kstep;
            const char* a3 = a2 + kstep; const char* b3 = b2 + kstep;
            unsigned wA[2][2];
            if constexpr (GATHER) {
                if (last && has_next) {
                    int t2 = tid; asm volatile("" : "+v"(t2));
#pragma unroll
                    for (int i = 0; i < 2; ++i) { int R, C; stage_rc(t2 * 16 + i * 8192, R, C);
#pragma unroll
                        for (int h = 0; h < 2; ++h) { unsigned r_ = nrid[h][i]; asm volatile("" : "+v"(r_));
                            nvA[h][i] = ((h * HALF + R) < nleft ? (r_ >> 1) : 0u) * (unsigned)(K * 2) + (unsigned)C * 2u; } }
                }
            }
#pragma unroll
            for (int h = 0; h < 2; ++h)
#pragma unroll
                for (int i = 0; i < 2; ++i) wA[h][i] = GATHER ? (last ? nvA[h][i] : vA[h][i]) : vA[h][i];
            PG8_LDB(B0, 0, 0); PG8_LDB(B1, 0, 1); PG8_SCHED; PG8_LDA(At, 0, 0); PG8_STAGE(PG8_SA(1, 1), a1, vA[1]);
            PG8_WAIT_V(8); PG8_WAIT_L(0); PG8_BAR; PG8_MMA(0, 0, At, B0); PG8_MMA(0, 1, At, B1); PG8_BAR; PG8_SCHED;
            PG8_LDA(At, 0, 1); PG8_STAGE(PG8_SB(0, 0), b2, voffB); PG8_STAGE(PG8_SB(0, 1), b2 + hstep, voffB); PG8_STAGE(PG8_SA(0, 0), a2, wA[0]);
            PG8_WAIT_V(8); PG8_WAIT_L(0); PG8_BAR; PG8_MMA(1, 0, At, B0); PG8_MMA(1, 1, At, B1); PG8_BAR; PG8_SCHED;
            PG8_LDB(B0, 1, 0); PG8_LDB(B1, 1, 1); PG8_SCHED; PG8_LDA(At, 1, 0); PG8_STAGE(PG8_SA(0, 1), a2, wA[1]);
            PG8_WAIT_V(8); PG8_WAIT_L(0); PG8_BAR; PG8_MMA(0, 0, At, B0); PG8_MMA(0, 1, At, B1); PG8_BAR; PG8_SCHED;
            PG8_LDA(At, 1, 1); PG8_STAGE(PG8_SB(1, 0), b3, voffB); PG8_STAGE(PG8_SB(1, 1), b3 + hstep, voffB); PG8_STAGE(PG8_SA(1, 0), a3, wA[0]);
            PG8_WAIT_V(8); PG8_WAIT_L(0); PG8_BAR; PG8_MMA(1, 0, At, B0); PG8_MMA(1, 1, At, B1); PG8_BAR; PG8_SCHED;
        }
        if (wr == 0) PG8_BAR;
        if constexpr (FP8) asm volatile("s_nop 15\n\ts_nop 7" ::: "memory");
        if constexpr (Epi::NPRE > 0) E(acc, cur, wr, wc, fr, fq, pre); else E(acc, cur, wr, wc, fr, fq);
        if (!has_next) break;
#pragma unroll
        for (int a = 0; a < 2; ++a)
#pragma unroll
            for (int b = 0; b < 2; ++b)
#pragma unroll
                for (int m = 0; m < 4; ++m)
#pragma unroll
                    for (int n = 0; n < 2; ++n) acc[a][b][m][n] = (f32x4){0.f, 0.f, 0.f, 0.f};
        cur = nxt; cA = nA; cB = nB; ++ui;
        if constexpr (GATHER) {
#pragma unroll
            for (int h = 0; h < 2; ++h)
#pragma unroll
                for (int i = 0; i < 2; ++i) vA[h][i] = nvA[h][i];
        }
        if (wr == 1) PG8_BAR;
    }
    PG8_WAIT_V(0);
    PG8_BAR;
#undef PG8_SA
#undef PG8_SB
#undef PG8_STAGE
#undef PG8_LDA
#undef PG8_LDB
#undef PG8_MMA
#undef PG8_LD8
#undef PG8_WAIT_V
#undef PG8_WAIT_L
#undef PG8_BAR
#undef PG8_SCHED
}
}


#define XB_TMO      128
#define XB_XCNT(j)  (256  + 64 * (j))
#define XB_XSUB(j)  (1280 + 64 * (j))
#define XB_XGEN(j)  (2304 + 64 * (j))
#define XB_TOP      3328
#define XB_TOPGEN   3392
#define XCD_BAR_WORDS 3456
#define XB_SPIN_CAP (1u << 20)
DI unsigned xb_ld(unsigned* p)              { return __hip_atomic_load(p, __ATOMIC_RELAXED, __HIP_MEMORY_SCOPE_AGENT); }
DI unsigned xb_add(unsigned* p, unsigned v) { return __hip_atomic_fetch_add(p, v, __ATOMIC_RELAXED, __HIP_MEMORY_SCOPE_AGENT); }
DI unsigned xb_xcc_id() { return (unsigned)__builtin_amdgcn_s_getreg((3 << 11) | 20) & 0xFu; }
#define XB_SPIN(cond, bar) do { unsigned _sp = 0; while (cond) { __builtin_amdgcn_s_sleep(1); \
    if ((++_sp & 255u) == 0u) { if (xb_ld(&(bar)[XB_TMO])) break; if (_sp > XB_SPIN_CAP) { atomicAdd(&(bar)[XB_TMO], 1u); break; } } } } while (0)
struct XcdBarrier { unsigned* bar; unsigned x; volatile LAS unsigned* st; };
DI XcdBarrier xcd_barrier_post(unsigned* bar, volatile LAS unsigned* st, bool leader) {
    XcdBarrier b; b.bar = bar; b.x = xb_xcc_id(); b.st = st;
    if (leader) (void)xb_add(&bar[XB_XCNT(b.x)], 1u);
    return b;
}
DI void xcd_barrier_complete(unsigned* bar, unsigned x, unsigned& nloc, unsigned& nx) {
    const unsigned G = gridDim.x;
    unsigned sum, cnt, mine, sp = 0u;
    for (;;) {
        sum = 0u; cnt = 0u; mine = 0u;
#pragma unroll
        for (unsigned j = 0; j < 16; ++j) { const unsigned c = xb_ld(&bar[XB_XCNT(j)]); sum += c; cnt += (c > 0u) ? 1u : 0u; mine = (j == x) ? c : mine; }
        if (sum == G) break;
        __builtin_amdgcn_s_sleep(1);
        if ((++sp & 255u) == 0u) { if (xb_ld(&bar[XB_TMO])) break; if (sp > XB_SPIN_CAP) { atomicAdd(&bar[XB_TMO], 1u); break; } }
    }
    nloc = mine > 0u ? mine : 1u; nx = cnt > 0u ? cnt : 1u;
}
DI void xcd_barrier(const XcdBarrier& b, bool leader) {
    asm volatile("s_waitcnt vmcnt(0)" ::: "memory");
    __syncthreads();
    if (leader) {
        unsigned* bar = b.bar;
        __builtin_amdgcn_s_waitcnt(0);
        unsigned nloc = b.st[0], nx = b.st[1];
        if (nloc == 0u) { xcd_barrier_complete(bar, b.x, nloc, nx); b.st[0] = nloc; b.st[1] = nx; }
        const unsigned old = xb_add(&bar[XB_XSUB(b.x)], 1u);
        const unsigned gen = old / nloc;
        if (old + 1u == (gen + 1u) * nloc) {
            __builtin_amdgcn_fence(__ATOMIC_RELEASE, "agent");
            asm volatile("s_waitcnt vmcnt(0)" ::: "memory");
            const unsigned og = xb_add(&bar[XB_TOP], 1u);
            const unsigned tg = og / nx;
            if (og + 1u == (tg + 1u) * nx) xb_add(&bar[XB_TOPGEN], 1u);
            else XB_SPIN(xb_ld(&bar[XB_TOPGEN]) == tg, bar);
            __builtin_amdgcn_fence(__ATOMIC_ACQUIRE, "agent");
            xb_add(&bar[XB_XGEN(b.x)], 1u);
            asm volatile("s_waitcnt vmcnt(0)" ::: "memory");
        } else {
            XB_SPIN(xb_ld(&bar[XB_XGEN(b.x)]) == gen, bar);
            __builtin_amdgcn_fence(__ATOMIC_ACQUIRE, "agent");
            asm volatile("s_waitcnt vmcnt(0)" ::: "memory");
        }
    }
    __syncthreads();
}

struct Args { const float* in[24]; float* out; unsigned char* ws; int ph_lo, ph_hi, dupk, dbg; };
struct Frame {
    lptr lds; int wave, vcu, G, bx;
    unsigned char* ws;
};

template <class RMap, bool FP8OUT = false>
DI void p0_transpose_item(const float* W, int ldn, int K, bf16_t* WT, LAS float* scr, int k0, int n0, int lane, const float* kscale, const RMap& rmap) {
    f32x4 v[8]; float ksc[8];
    const int r8 = lane >> 3, c4 = (lane & 7) * 4;
#pragma unroll
    for (int i = 0; i < 8; ++i) { v[i] = *(const f32x4*)(W + (size_t)(k0 + r8 + 8 * i) * ldn + n0 + c4); ksc[i] = kscale ? kscale[k0 + r8 + 8 * i] : 1.f; }
#pragma unroll
    for (int i = 0; i < 8; ++i) { LAS float* d = scr + (r8 + 8 * i) * 33 + c4; d[0] = v[i][0] * ksc[i]; d[1] = v[i][1] * ksc[i]; d[2] = v[i][2] * ksc[i]; d[3] = v[i][3] * ksc[i]; }
    asm volatile("s_waitcnt lgkmcnt(0)" ::: "memory");
    const int c = lane & 7;
#pragma unroll
    for (int j = 0; j < 4; ++j) { const int n = (lane >> 3) + 8 * j; const LAS float* s = scr + (8 * c) * 33 + n; float cs; const long orow = rmap(n0 + n, cs);
        if constexpr (FP8OUT) { u32x2 o; o.x = pk4_fp8(s[0 * 33] * cs, s[1 * 33] * cs, s[2 * 33] * cs, s[3 * 33] * cs); o.y = pk4_fp8(s[4 * 33] * cs, s[5 * 33] * cs, s[6 * 33] * cs, s[7 * 33] * cs);
            *(u32x2*)((unsigned char*)WT + (size_t)orow * K + k0 + 8 * c) = o; }
        else {
        u32x4 o; o.x = pk2(s[0 * 33] * cs, s[1 * 33] * cs); o.y = pk2(s[2 * 33] * cs, s[3 * 33] * cs); o.z = pk2(s[4 * 33] * cs, s[5 * 33] * cs); o.w = pk2(s[6 * 33] * cs, s[7 * 33] * cs);
        *(u32x4*)(WT + (size_t)orow * K + k0 + 8 * c) = o; } }
    asm volatile("s_waitcnt lgkmcnt(0)" ::: "memory");
}
struct RMapId { DI long operator()(int n, float& cs) const { cs = 1.f; return n; } };
struct RMapScale { float s; DI long operator()(int n, float& cs) const { cs = s; return n; } };
struct RMapKV { DI long operator()(int n, float& cs) const { cs = n < DM ? 0.015625f : 1.f; return n; } };
struct RMapWin {
    DI long operator()(int n, float& cs) const {
        cs = (n >= 256 && n < 512) ? 0.125f : 1.f;
        if (n < 512) { const int d = n & 63, p = (d < 32) ? 2 * d : 2 * (d - 32) + 1; return (n & ~63) + p; }
        return n;
    }
};
struct RMapGU { int up; DI long operator()(int n, float& cs) const { cs = 1.f; return (long)(n >> 7) * 256 + up * 128 + (n & 127); } };

DI void p0_prologue(Frame& F, const Args& a) {
    unsigned char* ws = F.ws;
    LAS float* scr = (LAS float*)(F.lds + F.wave * 16384);
    const int gw = F.vcu * NWAVES + F.wave, NGW = F.G * NWAVES, lane = lane_id(), tid0 = F.wave * 64 + lane;
    const float* g_mix = a.in[2]; const float* g_xa = a.in[10]; const float* g_mem = a.in[11]; const float* g_moe = a.in[15];
    constexpr int I_WIN = 16 * 112, I_SQ = 16 * 32, I_WKV = 16 * 64, I_GU = 32 * 16 * 16, I_DN = 32 * 8 * 32;
    constexpr int NITEMS = I_WIN + 3 * I_SQ + I_WKV;
    for (int it = gw; it < NITEMS; it += NGW) {
        int r = it;
        if (r < I_WIN) { p0_transpose_item(a.in[3], INW, DM, (bf16_t*)(ws + WS_WIN), scr, 64 * (r / 112), 32 * (r % 112), lane, g_mix, RMapWin{}); continue; } r -= I_WIN;
        if (r < I_SQ) { p0_transpose_item(a.in[9], DM, DM, (bf16_t*)(ws + WS_WOUT), scr, 64 * (r / 32), 32 * (r % 32), lane, nullptr, RMapId{}); continue; } r -= I_SQ;
        if (r < I_SQ) { p0_transpose_item<RMapScale, true>(a.in[12], DM, DM, (bf16_t*)(ws + WS_WQ), scr, 64 * (r / 32), 32 * (r % 32), lane, g_xa, RMapScale{0.0625f * 1.4426950408889634f * 512.f}); continue; }   r -= I_SQ;
        if (r < I_SQ) { p0_transpose_item<RMapScale, true>(a.in[14], DM, DM, (bf16_t*)(ws + WS_WO), scr, 64 * (r / 32), 32 * (r % 32), lane, nullptr, RMapScale{32.f}); continue; }   r -= I_SQ;
        { p0_transpose_item<RMapScale, true>(a.in[13], 2 * DM, DM, (bf16_t*)(ws + WS_WKV), scr, 64 * (r / 64), 32 * (r % 64), lane, g_mem, RMapScale{32.f}); }
    }
    {
        bf16_t* hi = (bf16_t*)(ws + WS_WR); bf16_t* lo = hi + 48 * 1024;
        const float* wg = a.in[16]; const float* wr_ = a.in[18];
        for (int idx = (F.vcu * NTHR + tid0); idx < 48 * 1024; idx += F.G * NTHR) {
            const int row = idx >> 10, k = idx & 1023; float v = 0.f;
            if (row < 32) { const int g = (row & 15) >> 2, i = (row & 3) + 4 * (row >> 4); v = wr_[(size_t)k * 32 + 8 * g + i] * g_moe[k]; }
            else if ((row & 3) == 0) { v = wg[(size_t)k * 4 + ((row - 32) >> 2)] * g_moe[k]; }
            const unsigned h = pk2(v, 0.f) & 0xffffu; const float r = v - bf2f((unsigned short)h);
            hi[idx] = (bf16_t)h; lo[idx] = (bf16_t)(pk2(r, 0.f) & 0xffffu);
        }
    }
    {
        f32x2* tab = (f32x2*)(ws + WS_ROPE);
        for (int idx = (F.vcu * NTHR + tid0); idx < SEQ * 32; idx += F.G * NTHR) {
            const int pos = idx >> 5, i = idx & 31; const float inv = powf(10000.0f, -(float)i / 32.0f); const float ang = (float)pos * inv;
            tab[idx] = (f32x2){cosf(ang), sinf(ang)};
        }
    }
    {
        float wgt[4][4][8];
#pragma unroll
        for (int jj = 0; jj < 4; ++jj)
#pragma unroll
            for (int c = 0; c < 4; ++c) { const int k = 256 * jj + 4 * lane + c; const float g = g_mix[k];
                const f32x4 w0 = *(const f32x4*)(a.in[3] + (size_t)k * INW + NP1), w1 = *(const f32x4*)(a.in[3] + (size_t)k * INW + NP1 + 4);
#pragma unroll
                for (int j = 0; j < 4; ++j) { wgt[jj][c][j] = w0[j] * g; wgt[jj][c][4 + j] = w1[j] * g; } }
        const float gb = a.in[7][lane & 7];
        bf16_t* xn0 = (bf16_t*)(ws + WS_XN0); float* gates = (float*)(ws + WS_GATES);
        f32x4 vA[4], vB[4];
#define P0_LOAD(S, row_) do { const int r_ = (row_) < NT ? (row_) : gw; const f32x4* xr_ = (const f32x4*)(a.in[0] + (size_t)r_ * DM) + lane; \
        _Pragma("unroll") for (int j = 0; j < 4; ++j) asm volatile("global_load_dwordx4 %0, %1, off" : "=v"(v##S[j]) : "v"(xr_ + 64 * j) : "memory"); } while (0)
#define P0_WAIT(n_, S) asm volatile("s_waitcnt vmcnt(" #n_ ")" : "+v"(v##S[0]), "+v"(v##S[1]), "+v"(v##S[2]), "+v"(v##S[3]) :: "memory")
#define P0_DO(S, row_) do { const int m_ = (row_) < NT ? (row_) : gw; float s = 0.f; \
        _Pragma("unroll") for (int j = 0; j < 4; ++j) s += (v##S[j].x * v##S[j].x + v##S[j].y * v##S[j].y) + (v##S[j].z * v##S[j].z + v##S[j].w * v##S[j].w); \
        const float rstd = rsqrtf(wave_sum(s) * (1.f / DM) + EPS); \
        float gacc[8]; _Pragma("unroll") for (int j = 0; j < 8; ++j) gacc[j] = 0.f; \
        _Pragma("unroll") for (int jj = 0; jj < 4; ++jj) _Pragma("unroll") for (int c = 0; c < 4; ++c) _Pragma("unroll") for (int j = 0; j < 8; ++j) gacc[j] += v##S[jj][c] * wgt[jj][c][j]; \
        unsigned long long* o8 = (unsigned long long*)(xn0 + (size_t)m_ * DM) + lane; \
        _Pragma("unroll") for (int j = 0; j < 4; ++j) o8[64 * j] = (unsigned long long)pk2(v##S[j].x * rstd, v##S[j].y * rstd) | ((unsigned long long)pk2(v##S[j].z * rstd, v##S[j].w * rstd) << 32); \
        float r4[4], r2[2], r1; \
        _Pragma("unroll") for (int j = 0; j < 4; ++j) { const float mine = (lane & 1) ? gacc[2 * j + 1] : gacc[2 * j], oth = (lane & 1) ? gacc[2 * j] : gacc[2 * j + 1]; r4[j] = mine + __shfl_xor(oth, 1); } \
        _Pragma("unroll") for (int j = 0; j < 2; ++j) { const float mine = (lane & 2) ? r4[2 * j + 1] : r4[2 * j], oth = (lane & 2) ? r4[2 * j] : r4[2 * j + 1]; r2[j] = mine + __shfl_xor(oth, 2); } \
        { const float mine = (lane & 4) ? r2[1] : r2[0], oth = (lane & 4) ? r2[0] : r2[1]; r1 = mine + __shfl_xor(oth, 4); } \
        r1 += __shfl_xor(r1, 8); r1 += __shfl_xor(r1, 16); r1 += __shfl_xor(r1, 32); \
        if (lane < 8) gates[(size_t)m_ * 8 + lane] = r1 * rstd + gb; \
        if (lane == 8) ((float*)(ws + WS_RMS))[m_] = __builtin_amdgcn_rcpf(rstd); } while (0)
        P0_LOAD(A, gw); P0_LOAD(B, gw + NGW);
        P0_WAIT(4, A); P0_DO(A, gw); P0_LOAD(A, gw + 2 * NGW);
        for (int m = gw + NGW; m < NT; m += 2 * NGW) {
            P0_WAIT(8, B); P0_DO(B, m); P0_LOAD(B, m + 2 * NGW);
            P0_WAIT(8, A); P0_DO(A, m + NGW); P0_LOAD(A, m + 3 * NGW);
        }
        asm volatile("s_waitcnt vmcnt(0)" ::: "memory");
#undef P0_LOAD
#undef P0_WAIT
#undef P0_DO
    }
    {
        unsigned char* memn = ws + WS_MEMN;
        for (int m = gw; m < MEMT; m += NGW) {
            const f32x4* xr = (const f32x4*)(a.in[1] + (size_t)m * DM) + lane;
            f32x4 v[4]; float s = 0.f;
#pragma unroll
            for (int j = 0; j < 4; ++j) { v[j] = xr[64 * j]; s += (v[j].x * v[j].x + v[j].y * v[j].y) + (v[j].z * v[j].z + v[j].w * v[j].w); }
            const float rstd = rsqrtf(wave_sum(s) * (1.f / DM) + EPS);
            unsigned* o4 = (unsigned*)(memn + (size_t)m * DM) + lane;
#pragma unroll
            for (int j = 0; j < 4; ++j) o4[64 * j] = pk4_fp8(v[j].x * rstd, v[j].y * rstd, v[j].z * rstd, v[j].w * rstd);
        }
    }
}


struct SchedDense {
    pg8::DenseOrder o; const char* A; const char* B; int K;
    DI bool next(int i, pg8::Unit& u) const { int pm, pn; if (!o.tile(i, pm, pn)) return false; u.A = A + (size_t)pm * 256 * K * 2; u.B = B + (size_t)pn * 256 * K * 2; u.pm = pm; u.pn = pn; u.tag = 0; u.aux = 0; return true; }
    DI unsigned arow(const pg8::Unit&, int) const { return 0u; }
};
struct SchedP1 {
    pg8::DenseOrder o1, o2; const char *A1, *B1, *A2, *B2; int n1;
    DI bool next(int i, pg8::Unit& u) const {
        int pm, pn;
        if (i < n1) { o1.tile(i, pm, pn); u.A = A1 + (size_t)pm * 256 * DM * 2; u.B = B1 + (size_t)pn * 256 * DM * 2; u.pm = pm; u.pn = pn; u.tag = 0; u.aux = 0; return true; }
        if (!o2.tile(i - n1, pm, pn)) return false;
        u.A = A2 + (size_t)pm * 256 * DM * 2; u.B = B2 + (size_t)pn * 256 * DM * 2; u.pm = pm; u.pn = pn; u.tag = 1; u.aux = 0; return true;
    }
    DI unsigned arow(const pg8::Unit&, int) const { return 0u; }
};

struct SchedKV {
    int first, step; const char *A, *B;
    DI bool next(int i, pg8::Unit& u) const { const int li = first + i * step; if (li >= 256) return false; u.pm = li >> 3; u.pn = li & 7; u.A = A + (size_t)u.pm * 256 * DM; u.B = B + (size_t)u.pn * 256 * DM;
        if (u.pn >= 4) { const char* t = u.A; u.A = u.B; u.B = t; }
        u.tag = 1; u.aux = 0; return true; }
    DI unsigned arow(const pg8::Unit&, int) const { return 0u; }
};
struct EpiP1 {
    static constexpr int NPRE = 0;
    bf16_t* proj; bf16_t* kvb; const f32x4* rope;
    DI void operator()(const f32x4 (&acc)[2][2][4][2], const pg8::Unit& u, int wr, int wc, int fr, int fq) const {
        asm volatile("" : "+v"(fr), "+v"(fq));
        const int row0 = u.pm * 256 + wr * 64 + fr, col0 = u.pn * 256 + wc * 32 + 8 * fq;
        const int mode = (u.tag == 1) ? 0 : (u.pn < 2 ? 1 : ((u.pn == 4 || u.pn == 5) ? 2 : ((u.pn == 12 || u.pn == 13) ? 3 : 0)));
        bf16_t* base = (u.tag == 1) ? kvb + ((size_t)(((u.pn >> 2) * NB + u.pm) * 4 + (u.pn & 3)) << 16) - (size_t)u.pm * 256 * 256 - (size_t)u.pn * 256 : proj; const int ldc = (u.tag == 1) ? 256 : NP1;
        f32x4 rt[2][4][2];
        if (mode == 1) {
#pragma unroll
            for (int ai = 0; ai < 2; ++ai)
#pragma unroll
                for (int m = 0; m < 4; ++m) { const f32x4* tp = rope + (size_t)((row0 + ai * 128 + m * 16) & (SEQ - 1)) * 16 + ((wc & 1) * 16 + 4 * fq) / 2; rt[ai][m][0] = tp[0]; rt[ai][m][1] = tp[1]; }
        }
        SCHED_FENCE();
#pragma unroll
        for (int ai = 0; ai < 2; ++ai)
#pragma unroll
            for (int m = 0; m < 4; ++m) {
                const int grow = row0 + ai * 128 + m * 16; bf16_t* rowp = base + (size_t)grow * ldc + col0;
                f32x4 t0 = {1.f, 0.f, 1.f, 0.f}, t1 = {1.f, 0.f, 1.f, 0.f};
                if (mode == 1) { t0 = rt[ai][m][0]; t1 = rt[ai][m][1]; }
#pragma unroll
                for (int bj = 0; bj < 2; ++bj) {
                    f32x4 v0 = acc[ai][bj][m][0], v1 = acc[ai][bj][m][1];
                    if (mode == 1) {
                        f32x4 r0, r1;
                        r0[0] = v0[0] * t0[0] - v0[1] * t0[1]; r0[1] = v0[0] * t0[1] + v0[1] * t0[0];
                        r0[2] = v0[2] * t0[2] - v0[3] * t0[3]; r0[3] = v0[2] * t0[3] + v0[3] * t0[2];
                        r1[0] = v1[0] * t1[0] - v1[1] * t1[1]; r1[1] = v1[0] * t1[1] + v1[1] * t1[0];
                        r1[2] = v1[2] * t1[2] - v1[3] * t1[3]; r1[3] = v1[2] * t1[3] + v1[3] * t1[2];
                        v0 = r0; v1 = r1;
                    } else if (mode == 2) {
#pragma unroll
                        for (int j = 0; j < 4; ++j) { v0[j] = silu_f(v0[j]); v1[j] = silu_f(v1[j]); }
                    } else if (mode == 3) {
#pragma unroll
                        for (int j = 0; j < 4; ++j) { v0[j] = sigm_f(v0[j]); v1[j] = sigm_f(v1[j]); }
                    }
                    u32x4 w; w.x = pk2(v0[0], v0[1]); w.y = pk2(v0[2], v0[3]); w.z = pk2(v1[0], v1[1]); w.w = pk2(v1[2], v1[3]);
                    *(u32x4*)(rowp + bj * 128) = w;
                }
            }
    }
};
struct EpiKV8 {
    static constexpr int NPRE = 0;
    unsigned char* kv8;
    DI void operator()(const f32x4 (&acc)[2][2][4][2], const pg8::Unit& u, int wr, int wc, int fr, int fq) const {
        asm volatile("" : "+v"(fr), "+v"(fq));
        unsigned char* blk = kv8 + ((size_t)(((u.pn >> 2) * NB + u.pm) * 4 + (u.pn & 3)) << 16);
#pragma unroll
        for (int ai = 0; ai < 2; ++ai)
#pragma unroll
            for (int m = 0; m < 4; ++m)
#pragma unroll
                for (int bj = 0; bj < 2; ++bj) { const f32x4 v0 = acc[ai][bj][m][0], v1 = acc[ai][bj][m][1];
                    u32x2 w8; w8.x = pk4_fp8(v0[0], v0[1], v0[2], v0[3]); w8.y = pk4_fp8(v1[0], v1[1], v1[2], v1[3]);
                    *(u32x2*)(blk + (ai * 128 + wr * 64 + m * 16 + fr) * 256 + bj * 128 + wc * 32 + 8 * fq) = w8; }
    }
};
struct EpiP3 {
    static constexpr int NPRE = 0;
    const bf16_t* xn0; const float* rms; bf16_t* x1b; float* ssq; unsigned char* x1q8;
    DI void operator()(const f32x4 (&acc)[2][2][4][2], const pg8::Unit& u, int wr, int wc, int fr, int fq) const {
        asm volatile("" : "+v"(fr), "+v"(fq));
        const int row0 = u.pm * 256 + wr * 64 + fr, col0 = u.pn * 256 + wc * 32 + 8 * fq;
#pragma unroll
        for (int ai = 0; ai < 2; ++ai) {
            u32x4 xv[4][2]; float rm[4];
#pragma unroll
            for (int m = 0; m < 4; ++m) { rm[m] = rms[row0 + ai * 128 + m * 16];
#pragma unroll
                for (int bj = 0; bj < 2; ++bj) xv[m][bj] = *(const u32x4*)(xn0 + (size_t)(row0 + ai * 128 + m * 16) * DM + col0 + bj * 128); }
            SCHED_FENCE();
#pragma unroll
            for (int m = 0; m < 4; ++m) {
                const int grow = row0 + ai * 128 + m * 16; float s = 0.f;
#pragma unroll
                for (int bj = 0; bj < 2; ++bj) {
                    const u32x4 r = xv[m][bj]; const float rmm = rm[m];
                    const f32x4 v0 = acc[ai][bj][m][0] + (f32x4){bflo(r.x), bfhi(r.x), bflo(r.y), bfhi(r.y)} * rmm, v1 = acc[ai][bj][m][1] + (f32x4){bflo(r.z), bfhi(r.z), bflo(r.w), bfhi(r.w)} * rmm;
                    u32x4 w; w.x = pk2(v0[0], v0[1]); w.y = pk2(v0[2], v0[3]); w.z = pk2(v1[0], v1[1]); w.w = pk2(v1[2], v1[3]);
                    *(u32x4*)(x1b + (size_t)grow * DM + col0 + bj * 128) = w;
                    { u32x2 w8; w8.x = pk4_fp8(v0[0], v0[1], v0[2], v0[3]); w8.y = pk4_fp8(v1[0], v1[1], v1[2], v1[3]); *(u32x2*)(x1q8 + (size_t)grow * DM + col0 + bj * 128) = w8; }
                    const float a0 = bflo(w.x), a1 = bfhi(w.x), a2 = bflo(w.y), a3 = bfhi(w.y), a4 = bflo(w.z), a5 = bfhi(w.z), a6 = bflo(w.w), a7 = bfhi(w.w);
                    s += (a0 * a0 + a1 * a1) + (a2 * a2 + a3 * a3) + (a4 * a4 + a5 * a5) + (a6 * a6 + a7 * a7);
                }
                s += __shfl_xor(s, 16); s += __shfl_xor(s, 32);
                if (fq == 0) ssq[(size_t)grow * 16 + u.pn * 4 + wc] = s;
            }
            SCHED_FENCE();
        }
    }
};

constexpr int RQ_OFF = 0, RK_OFF = 18432, RV_OFF = 36864, RRT_OFF = 73728, RNW_OFF = 92160, RSTG_OFF = 94208;
DI void headnorm_store(f32x4 (&x)[8], const LAS float* nw, const u32x4 (&gq)[4], lptr stg, bf16_t* outw, int lane, int exor) {
    const int fr = lane & 15, fq = lane >> 4;
#pragma unroll
    for (int it = 0; it < 4; ++it) *(LAS u32x4*)(stg + (fq + 4 * it) * 272 + 16 * fr) = gq[it];
    float s = 0.f;
#pragma unroll
    for (int eb = 0; eb < 8; ++eb) s += (x[eb][0] + x[eb][1]) + (x[eb][2] + x[eb][3]);
    s += __shfl_xor(s, 16); s += __shfl_xor(s, 32);
    const float mu = s * (1.f / 128.f); float q = 0.f;
#pragma unroll
    for (int eb = 0; eb < 8; ++eb) { x[eb] = x[eb] - mu; q += (x[eb][0] * x[eb][0] + x[eb][1] * x[eb][1]) + (x[eb][2] * x[eb][2] + x[eb][3] * x[eb][3]); }
    q += __shfl_xor(q, 16); q += __shfl_xor(q, 32);
    const float rs = rsqrtf(q * (1.f / 128.f) + EPS);
#pragma unroll
    for (int eb = 0; eb < 8; ++eb) {
        const int e0 = 16 * (eb ^ exor) + 4 * fq;
        const f32x4 wv = *(const LAS f32x4*)(nw + e0); const u32x2 gv = *(const LAS u32x2*)(stg + fr * 272 + e0 * 2);
        u32x2 o; o.x = pk2(x[eb][0] * rs * wv[0] * bflo(gv.x), x[eb][1] * rs * wv[1] * bfhi(gv.x)); o.y = pk2(x[eb][2] * rs * wv[2] * bflo(gv.y), x[eb][3] * rs * wv[3] * bfhi(gv.y));
        *(LAS u32x2*)(stg + fr * 272 + e0 * 2) = o;
    }
#pragma unroll
    for (int it = 0; it < 4; ++it) { const u32x4 v = *(const LAS u32x4*)(stg + (fq + 4 * it) * 272 + 16 * fr); *(u32x4*)(outw + (size_t)(fq + 4 * it) * DM + 8 * fr) = v; }
}
DI void ret_item(Frame& F, const Args& a, int b, int h) {
    const lptr L = F.lds; const int w = F.wave;
    const bf16_t* proj = (const bf16_t*)(F.ws + WS_PROJ); bf16_t* mix = (bf16_t*)(F.ws + WS_MIX);
    const float lg2 = log1pf(-exp2f(-5.f - (float)h)) * 1.4426950408889634f;
    const float g128 = exp2f(128.f * lg2);
    const int db = w >> 1, ebase = 4 * (w & 1);
    LAS float* nw = (LAS float*)(L + RNW_OFF);
    { const int t_ = F.wave * 64 + lane_id(); if (t_ < 128) nw[t_] = a.in[4][h * 128 + t_]; }
    f32x4 Racc[4];
#pragma unroll
    for (int t = 0; t < 4; ++t) Racc[t] = (f32x4){0.f, 0.f, 0.f, 0.f};
    for (int i = F.wave * 64 + lane_id(); i < 18432 / 16; i += NTHR) *(LAS u32x4*)(L + RRT_OFF + i * 16) = (u32x4){0u, 0u, 0u, 0u};
    u32x4 pq[2], pk[2], pv[4];
    {
        const int tid = F.wave * 64 + lane_id(); const size_t row0 = (size_t)b * SEQ;
#pragma unroll
        for (int i = 0; i < 2; ++i) { const int p = tid + i * NTHR, r = p >> 3, ch = p & 7; const bf16_t* src = proj + (row0 + r) * NP1 + h * 64 + ch * 8; pq[i] = *(const u32x4*)src; pk[i] = *(const u32x4*)(src + 256); }
#pragma unroll
        for (int i = 0; i < 4; ++i) { const int p = tid + i * NTHR, r = p >> 4, ch = p & 15; pv[i] = *(const u32x4*)(proj + (row0 + r) * NP1 + 512 + h * 128 + ch * 8); }
    }
    for (int c = 0; c < 16; ++c) {
        const size_t row0 = (size_t)b * SEQ + c * 128;
        int tid = F.wave * 64 + lane_id(); asm volatile("" : "+v"(tid));
        const int lane = tid & 63, fr = lane & 15, fq = lane >> 4;
        __syncthreads();
        if (c > 0) {
#pragma unroll
            for (int t = 0; t < 4; ++t) { u32x2 pk_; pk_.x = pk2(Racc[t][0], Racc[t][1]); pk_.y = pk2(Racc[t][2], Racc[t][3]);
                *(LAS u32x2*)(L + RRT_OFF + (16 * (ebase + t) + fr) * 144 + (16 * db + 4 * fq) * 2) = pk_; }
        }
#pragma unroll
        for (int i = 0; i < 2; ++i) { const int p = tid + i * NTHR, r = p >> 3, ch = p & 7;
            *(LAS u32x4*)(L + RQ_OFF + r * 144 + ch * 16) = pq[i]; *(LAS u32x4*)(L + RK_OFF + r * 144 + ch * 16) = pk[i]; }
#pragma unroll
        for (int i = 0; i < 4; ++i) { const int p = tid + i * NTHR, r = p >> 4, ch = p & 15; u32x4 v = pv[i];
            const float sc = exp2f((float)(127 - r) * lg2);
            v.x = pk2(bflo(v.x) * sc, bfhi(v.x) * sc); v.y = pk2(bflo(v.y) * sc, bfhi(v.y) * sc); v.z = pk2(bflo(v.z) * sc, bfhi(v.z) * sc); v.w = pk2(bflo(v.w) * sc, bfhi(v.w) * sc);
            *(LAS u32x4*)(L + RV_OFF + r * 288 + ch * 16) = v; }
        __syncthreads();
        {
            const size_t rown = (size_t)b * SEQ + (c < 15 ? c + 1 : c) * 128;
#pragma unroll
            for (int i = 0; i < 2; ++i) { const int p = tid + i * NTHR, r = p >> 3, ch = p & 7; const bf16_t* src = proj + (rown + r) * NP1 + h * 64 + ch * 8; pq[i] = *(const u32x4*)src; pk[i] = *(const u32x4*)(src + 256); }
#pragma unroll
            for (int i = 0; i < 4; ++i) { const int p = tid + i * NTHR, r = p >> 4, ch = p & 15; pv[i] = *(const u32x4*)(proj + (rown + r) * NP1 + 512 + h * 128 + ch * 8); }
        }
        const size_t grow = row0 + 16 * w + fr;
        u32x4 gq[4];
#pragma unroll
        for (int it = 0; it < 4; ++it) gq[it] = *(const u32x4*)(proj + (row0 + 16 * w + fq + 4 * it) * NP1 + 1024 + h * 128 + 8 * fr);
        bf16x8 qf[2];
#pragma unroll
        for (int ks = 0; ks < 2; ++ks) qf[ks] = lds16(L + RQ_OFF + (16 * w + fr) * 144 + (32 * ks + 8 * fq) * 2);
        f32x4 S[8];
        {
            bf16x8 kf[2][4];
#pragma unroll
            for (int j = 0; j < 4; ++j) kf[0][j] = lds16(L + RK_OFF + (16 * (j >> 1) + fr) * 144 + (32 * (j & 1) + 8 * fq) * 2);
#pragma unroll
            for (int g = 0; g < 4; ++g) {
                if (g < 3) {
#pragma unroll
                    for (int j = 0; j < 4; ++j) kf[(g + 1) & 1][j] = lds16(L + RK_OFF + (16 * (2 * (g + 1) + (j >> 1)) + fr) * 144 + (32 * (j & 1) + 8 * fq) * 2);
                }
                SCHED_FENCE();
#pragma unroll
                for (int j = 0; j < 4; ++j) { const int mb = 2 * g + (j >> 1); if ((j & 1) == 0) S[mb] = (f32x4){0.f, 0.f, 0.f, 0.f}; S[mb] = mfma16(kf[g & 1][j], qf[j & 1], S[mb]); }
                SCHED_FENCE();
            }
#pragma unroll
            for (int mb = 0; mb < 8; ++mb)
#pragma unroll
                for (int i = 0; i < 4; ++i) if (16 * mb + 4 * fq + i > 16 * w + fr) S[mb][i] = 0.f;
        }
        f32x4 acc[8];
        {
            bf16x8 rf_[2][4];
#pragma unroll
            for (int j = 0; j < 4; ++j) rf_[0][j] = lds16(L + RRT_OFF + (16 * ((j >> 1) ^ ebase) + fr) * 144 + (32 * (j & 1) + 8 * fq) * 2);
#pragma unroll
            for (int g = 0; g < 4; ++g) {
                if (g < 3) {
#pragma unroll
                    for (int j = 0; j < 4; ++j) rf_[(g + 1) & 1][j] = lds16(L + RRT_OFF + (16 * ((2 * (g + 1) + (j >> 1)) ^ ebase) + fr) * 144 + (32 * (j & 1) + 8 * fq) * 2);
                }
                SCHED_FENCE();
#pragma unroll
                for (int j = 0; j < 4; ++j) { const int eb = 2 * g + (j >> 1); if ((j & 1) == 0) acc[eb] = (f32x4){0.f, 0.f, 0.f, 0.f}; acc[eb] = mfma16(rf_[g & 1][j], qf[j & 1], acc[eb]); }
                SCHED_FENCE();
            }
#pragma unroll
            for (int eb = 0; eb < 8; ++eb) acc[eb] = acc[eb] * g128;
        }
#pragma unroll
        for (int t = 0; t < 4; ++t) Racc[t] = Racc[t] * g128;
        {
            const int tcol = 4 * (fr & 3);
            s16x4 vb[2][8];
#define RV_LOAD(buf, s_, half_) do { const int trow_ = 32 * (s_) + 4 * fq + (fr >> 2); _Pragma("unroll") for (int e_ = 0; e_ < 4; ++e_) { \
                vb[buf][2 * e_] = ldstr(L + RV_OFF + trow_ * 288 + (16 * ((4 * (half_) + e_) ^ ebase) + tcol) * 2); vb[buf][2 * e_ + 1] = ldstr(L + RV_OFF + (trow_ + 16) * 288 + (16 * ((4 * (half_) + e_) ^ ebase) + tcol) * 2); } } while (0)
            RV_LOAD(0, 0, 0);
#pragma unroll
            for (int s = 0; s < 4; ++s) {
                u32x4 pw; pw.x = pk2(S[2 * s][0], S[2 * s][1]); pw.y = pk2(S[2 * s][2], S[2 * s][3]); pw.z = pk2(S[2 * s + 1][0], S[2 * s + 1][1]); pw.w = pk2(S[2 * s + 1][2], S[2 * s + 1][3]);
                const bf16x8 pf = __builtin_bit_cast(bf16x8, pw);
                const int trow = 32 * s + 4 * fq + (fr >> 2);
                const bf16x8 ktf = cat4(ldstr(L + RK_OFF + trow * 144 + (16 * db + tcol) * 2), ldstr(L + RK_OFF + (trow + 16) * 144 + (16 * db + tcol) * 2));
#pragma unroll
                for (int hf = 0; hf < 2; ++hf) {
                    const int bi = 2 * s + hf;
                    if (bi < 7) RV_LOAD((bi + 1) & 1, (bi + 1) >> 1, (bi + 1) & 1);
                    SCHED_FENCE();
#pragma unroll
                    for (int e = 0; e < 4; ++e) { const int eb = 4 * hf + e; const bf16x8 vf = cat4(vb[bi & 1][2 * e], vb[bi & 1][2 * e + 1]);
                        acc[eb] = mfma16(vf, pf, acc[eb]);
                        if (hf == 0) Racc[e] = mfma16(ktf, vf, Racc[e]); }
                    SCHED_FENCE();
                }
            }
#undef RV_LOAD
        }
        const float rowf = exp2f((float)(16 * w + fr - 127) * lg2);
#pragma unroll
        for (int eb = 0; eb < 8; ++eb) acc[eb] = acc[eb] * rowf;
        headnorm_store(acc, nw, gq, L + RSTG_OFF + w * 4352, mix + (row0 + 16 * w) * DM + h * 128, lane, ebase);
    }
}

constexpr int MQ_OFF = 0, MK_OFF = 34816, MV_OFF = 69632, MCT_OFF = 106496, MCW_OFF = 145664, MGC_OFF = 150784, MGS_OFF = 152320, MNW_OFF = 152704;
DI float logsig_f(float x) { return fminf(x, 0.f) - log1pf(__expf(-fabsf(x))); }
DI void mlstm_item(Frame& F, const Args& a, int b, int h, int midx) {
    const lptr L = F.lds; const int w = F.wave;
    const bf16_t* proj = (const bf16_t*)(F.ws + WS_PROJ); bf16_t* mix = (bf16_t*)(F.ws + WS_MIX);
    const float* gates = (const float*)(F.ws + WS_GATES);
    f32x4* garr = (f32x4*)(F.ws + WS_GARR) + (size_t)midx * SEQ;
    LAS float* cw = (LAS float*)(L + MCW_OFF);
    LAS float* gcu = (LAS float*)(L + MGC_OFF); LAS float* gcr = gcu + 128; LAS float* gcd = gcu + 256;
    LAS float* gs_old = (LAS float*)(L + MGS_OFF); LAS float* gs_loc = gs_old + 16; LAS float* gs_rat = gs_old + 32; LAS float* gs_M = gs_old + 48; LAS float* gs_bt = gs_old + 64; LAS float* gs_mp = gs_old + 80;
    LAS float* nw = (LAS float*)(L + MNW_OFF);
    {
        const int lane = lane_id(), tid = w * 64 + lane;
        for (int i = tid; i < 39168 / 16; i += NTHR) *(LAS u32x4*)(L + MCT_OFF + i * 16) = (u32x4){0u, 0u, 0u, 0u};
        if (tid < 128) { *(LAS u32x4*)(L + MV_OFF + tid * 288 + 256) = (u32x4){0x00003F80u, 0u, 0u, 0u}; *(LAS u32x4*)(L + MV_OFF + tid * 288 + 272) = (u32x4){0u, 0u, 0u, 0u};
#pragma unroll
            for (int j = 0; j < 4; ++j) { cw[j * 128 + tid] = a.in[5][j * 1024 + h * 128 + tid]; cw[640 + j * 128 + tid] = a.in[5][j * 1024 + 512 + h * 128 + tid]; }
            cw[512 + tid] = a.in[6][h * 128 + tid]; cw[640 + 512 + tid] = a.in[6][512 + h * 128 + tid]; nw[tid] = a.in[8][h * 128 + tid]; }
        LAS float* tb = (LAS float*)L; LAS float* tg = tb + 2048; LAS float* tpm = tb + 4096;
#pragma unroll
        for (int cc = 0; cc < 2; ++cc) {
            const int c = 2 * w + cc; const float* gp = gates + ((size_t)b * SEQ + c * 128 + 2 * lane) * 8;
            const float ig0 = gp[h], ig1 = gp[8 + h]; const float lf0 = logsig_f(gp[4 + h]), lf1 = logsig_f(gp[12 + h]);
            float incl = lf0 + lf1;
#pragma unroll
            for (int o = 1; o < 64; o <<= 1) { const float t = __shfl_up(incl, o); if (lane >= o) incl += t; }
            const float b1 = incl, b0 = incl - lf1;
            const float g0 = ig0 - b0, g1 = ig1 - b1;
            float pmi = fmaxf(g0, g1);
#pragma unroll
            for (int o = 1; o < 64; o <<= 1) { const float t = __shfl_up(pmi, o); if (lane >= o) pmi = fmaxf(pmi, t); }
            float pme = __shfl_up(pmi, 1); if (lane == 0) pme = -INFINITY;
            const int r = c * 128 + 2 * lane;
            tb[r] = b0; tb[r + 1] = b1; tg[r] = g0; tg[r + 1] = g1; tpm[r] = fmaxf(pme, g0); tpm[r + 1] = pmi;
            if (lane == 63) { gs_M[c] = pmi; gs_bt[c] = incl; }
        }
        __syncthreads();
        if (tid == 0) { float mprev = 0.f;
            for (int c = 0; c < 16; ++c) { const float M = gs_M[c], bt = gs_bt[c]; gs_mp[c] = mprev; const float mloc = bt + M, mnew = fmaxf(bt + mprev, mloc);
                gs_old[c] = __expf(bt + mprev - mnew); gs_loc[c] = __expf(mloc - mnew); gs_rat[c] = __expf(fminf(mprev - M, 80.f)); mprev = mnew; } }
        __syncthreads();
#pragma unroll
        for (int k = 0; k < 4; ++k) { const int r = tid + NTHR * k, c = r >> 7; const float bb = tb[r], M = gs_M[c]; const float mt = bb + fmaxf(tpm[r], gs_mp[c]);
            garr[r] = (f32x4){__expf(tg[r] - M), __expf(bb + M - mt), __expf(-mt), 0.f}; }
        __syncthreads();
    }
    f32x4 C[9];
#pragma unroll
    for (int t = 0; t < 9; ++t) C[t] = (f32x4){0.f, 0.f, 0.f, 0.f};
    u32x4 vv[4], xr[11]; f32x4 ga = {0.f, 0.f, 0.f, 0.f};
#define ML_LOADX(cidx) do { const size_t rown_ = (size_t)b * SEQ + (size_t)(cidx) * 128; const int col_ = 1536 + (w >= 4 ? 512 : 0) + h * 128 + 8 * cgp; \
        _Pragma("unroll") for (int rr = 0; rr < 11; ++rr) { const int lr = 8 * rb8 + rr - 3; const bool ok_ = ((cidx) > 0) || (lr >= 0); \
            xr[rr] = ok_ ? *(const u32x4*)(proj + (size_t)((long)rown_ + lr) * NP1 + col_) : (u32x4){0u, 0u, 0u, 0u}; } } while (0)
#define ML_LOADS(cidx) do { const size_t rown_ = (size_t)b * SEQ + (size_t)(cidx) * 128; \
        _Pragma("unroll") for (int i = 0; i < 4; ++i) { const int p = tid + i * NTHR, r = p >> 4, ch = p & 15; vv[i] = *(const u32x4*)(proj + (rown_ + r) * NP1 + 2560 + h * 128 + ch * 8); } \
        if (tid < 128) ga = garr[(cidx) * 128 + tid]; } while (0)
    { const int tid = w * 64 + lane_id(), cgp = tid & 15, rb8 = (tid & 255) >> 4; ML_LOADS(0); ML_LOADX(0); }
    for (int c = 0; c < 16; ++c) {
        const size_t row0 = (size_t)b * SEQ + c * 128;
        int tid = F.wave * 64 + lane_id(); asm volatile("" : "+v"(tid));
        const int lane = tid & 63, fr = lane & 15, fq = lane >> 4, cgp = tid & 15, rb8 = (tid & 255) >> 4;
        __syncthreads();
        if (c > 0) {
#pragma unroll
            for (int eb = 0; eb < 9; ++eb) { u32x2 pk; pk.x = pk2(C[eb][0], C[eb][1]); pk.y = pk2(C[eb][2], C[eb][3]);
                *(LAS u32x2*)(L + MCT_OFF + (16 * eb + fr) * 272 + (16 * w + 4 * fq) * 2) = pk; }
        }
#pragma unroll
        for (int i = 0; i < 4; ++i) { const int p = tid + i * NTHR, r = p >> 4, ch = p & 15; *(LAS u32x4*)(L + MV_OFF + r * 288 + ch * 16) = vv[i]; }
        if (tid < 128) { gcu[tid] = ga[0]; gcr[tid] = ga[1]; gcd[tid] = ga[2]; }
        {
            const int isk = (w >= 4) ? 1 : 0; f32x2 wv[4][4], bv[4];
#pragma unroll
            for (int j = 0; j < 5; ++j) { const f32x4 w0 = *(const LAS f32x4*)(cw + isk * 640 + j * 128 + 8 * cgp), w1 = *(const LAS f32x4*)(cw + isk * 640 + j * 128 + 8 * cgp + 4);
                if (j < 4) { wv[j][0] = (f32x2){w0[0], w0[1]}; wv[j][1] = (f32x2){w0[2], w0[3]}; wv[j][2] = (f32x2){w1[0], w1[1]}; wv[j][3] = (f32x2){w1[2], w1[3]}; }
                else { bv[0] = (f32x2){w0[0], w0[1]}; bv[1] = (f32x2){w0[2], w0[3]}; bv[2] = (f32x2){w1[0], w1[1]}; bv[3] = (f32x2){w1[2], w1[3]}; } }
            const float osc = isk ? 0.08838834764831845f : 1.f;
            const lptr tile = L + (isk ? MK_OFF : MQ_OFF) + cgp * 16;
            f32x2 xf[11][4];
#pragma unroll
            for (int rr = 0; rr < 11; ++rr)
#pragma unroll
                for (int p = 0; p < 4; ++p) xf[rr][p] = (f32x2){bflo(xr[rr][p]), bfhi(xr[rr][p])};
#pragma unroll
            for (int r = 0; r < 8; ++r) { u32x4 o;
#pragma unroll
                for (int p = 0; p < 4; ++p) { f32x2 acc_ = bv[p];
#pragma unroll
                    for (int j = 0; j < 4; ++j) acc_ = __builtin_elementwise_fma(wv[j][p], xf[r + j][p], acc_);
                    o[p] = pk2(silu_f(acc_[0]) * osc, silu_f(acc_[1]) * osc); }
                *(LAS u32x4*)(tile + (8 * rb8 + r) * 272) = o; }
        }
        __syncthreads();
        { const int cn = c < 15 ? c + 1 : c; ML_LOADS(cn); }
        const size_t grow = row0 + 16 * w + fr;
        u32x4 gq[4];
#pragma unroll
        for (int it = 0; it < 4; ++it) gq[it] = *(const u32x4*)(proj + (row0 + 16 * w + fq + 4 * it) * NP1 + 3072 + h * 128 + 8 * fr);
        bf16x8 qf[4];
#pragma unroll
        for (int ks = 0; ks < 4; ++ks) qf[ks] = lds16(L + MQ_OFF + (16 * w + fr) * 272 + (32 * ks + 8 * fq) * 2);
        const float so = gs_old[c], sl = gs_loc[c], rat = gs_rat[c];
        f32x4 acc[9];
        {
            bf16x8 cf[2][4];
#pragma unroll
            for (int ks = 0; ks < 4; ++ks) cf[0][ks] = lds16(L + MCT_OFF + fr * 272 + (32 * ks + 8 * fq) * 2);
#pragma unroll
            for (int eb = 0; eb < 9; ++eb) {
                if (eb < 8) {
#pragma unroll
                    for (int ks = 0; ks < 4; ++ks) cf[(eb + 1) & 1][ks] = lds16(L + MCT_OFF + (16 * (eb + 1) + fr) * 272 + (32 * ks + 8 * fq) * 2);
                }
                SCHED_FENCE();
                acc[eb] = (f32x4){0.f, 0.f, 0.f, 0.f};
#pragma unroll
                for (int ks = 0; ks < 4; ++ks) acc[eb] = mfma16(cf[eb & 1][ks], qf[ks], acc[eb]);
                SCHED_FENCE();
            }
#pragma unroll
            for (int eb = 0; eb < 9; ++eb) { acc[eb] = acc[eb] * rat; C[eb] = C[eb] * so; }
        }
        {
            const int tcol = 4 * (fr & 3);
            s16x4 vb[2][6];
#define MV_LOAD(buf, s_, g_) do { const int trow_ = 32 * (s_) + 4 * fq + (fr >> 2); _Pragma("unroll") for (int e_ = 0; e_ < 3; ++e_) { \
                vb[buf][2 * e_] = ldstr(L + MV_OFF + trow_ * 288 + (16 * (3 * (g_) + e_) + tcol) * 2); vb[buf][2 * e_ + 1] = ldstr(L + MV_OFF + (trow_ + 16) * 288 + (16 * (3 * (g_) + e_) + tcol) * 2); } } while (0)
#pragma unroll
            for (int hf = 0; hf < 2; ++hf) {
                f32x4 S[4];
                {
                    bf16x8 kf[2][4];
#pragma unroll
                    for (int ks = 0; ks < 4; ++ks) kf[0][ks] = lds16(L + MK_OFF + (64 * hf + fr) * 272 + (32 * ks + 8 * fq) * 2);
#pragma unroll
                    for (int sq = 0; sq < 4; ++sq) {
                        if (sq < 3) {
#pragma unroll
                            for (int ks = 0; ks < 4; ++ks) kf[(sq + 1) & 1][ks] = lds16(L + MK_OFF + (64 * hf + 16 * (sq + 1) + fr) * 272 + (32 * ks + 8 * fq) * 2);
                        } else { MV_LOAD(0, 2 * hf, 0); }
                        SCHED_FENCE();
                        S[sq] = (f32x4){0.f, 0.f, 0.f, 0.f};
#pragma unroll
                        for (int ks = 0; ks < 4; ++ks) S[sq] = mfma16(kf[sq & 1][ks], qf[ks], S[sq]);
                        SCHED_FENCE();
                    }
                }
#pragma unroll
                for (int sq = 0; sq < 4; ++sq) { const int sb = 4 * hf + sq; const f32x4 u4 = *(const LAS f32x4*)(gcu + 16 * sb + 4 * fq);
#pragma unroll
                    for (int i = 0; i < 4; ++i) S[sq][i] = (16 * sb + 4 * fq + i > 16 * w + fr) ? 0.f : S[sq][i] * u4[i]; }
#pragma unroll
                for (int s2 = 0; s2 < 2; ++s2) { const int s = 2 * hf + s2;
                    u32x4 pw; pw.x = pk2(S[2 * s2][0], S[2 * s2][1]); pw.y = pk2(S[2 * s2][2], S[2 * s2][3]); pw.z = pk2(S[2 * s2 + 1][0], S[2 * s2 + 1][1]); pw.w = pk2(S[2 * s2 + 1][2], S[2 * s2 + 1][3]);
                    const bf16x8 pf = __builtin_bit_cast(bf16x8, pw);
                    const int trow = 32 * s + 4 * fq + (fr >> 2);
                    u32x4 kt = __builtin_bit_cast(u32x4, cat4(ldstr(L + MK_OFF + trow * 272 + (16 * w + tcol) * 2), ldstr(L + MK_OFF + (trow + 16) * 272 + (16 * w + tcol) * 2)));
                    const f32x4 ua = *(const LAS f32x4*)(gcu + 32 * s + 4 * fq) * sl, ub = *(const LAS f32x4*)(gcu + 32 * s + 16 + 4 * fq) * sl;
                    kt.x = pk2(bflo(kt.x) * ua[0], bfhi(kt.x) * ua[1]); kt.y = pk2(bflo(kt.y) * ua[2], bfhi(kt.y) * ua[3]); kt.z = pk2(bflo(kt.z) * ub[0], bfhi(kt.z) * ub[1]); kt.w = pk2(bflo(kt.w) * ub[2], bfhi(kt.w) * ub[3]);
                    const bf16x8 ktf = __builtin_bit_cast(bf16x8, kt);
#pragma unroll
                    for (int g = 0; g < 3; ++g) { const int bi = 3 * s2 + g;
                        if (bi < 5) MV_LOAD((bi + 1) & 1, 2 * hf + (bi + 1) / 3, (bi + 1) % 3);
                        SCHED_FENCE();
#pragma unroll
                        for (int e = 0; e < 3; ++e) { const int eb = 3 * g + e; const bf16x8 vf = cat4(vb[bi & 1][2 * e], vb[bi & 1][2 * e + 1]);
                            acc[eb] = mfma16(vf, pf, acc[eb]);
                            C[eb] = mfma16(ktf, vf, C[eb]); }
                        SCHED_FENCE();
                    }
                }
            }
#undef MV_LOAD
        }
        { const int cn = c < 15 ? c + 1 : c; ML_LOADX(cn); }
        {
            const int t = 16 * w + fr; const float rf = gcr[t], dc = gcd[t];
            float den = rf * acc[8][0]; den = __shfl(den, fr);
            const float sc = rf / fmaxf(fabsf(den), dc);
            f32x4 hv[8];
#pragma unroll
            for (int eb = 0; eb < 8; ++eb) hv[eb] = acc[eb] * sc;
            headnorm_store(hv, nw, gq, L + MQ_OFF + 16 * w * 272, mix + (row0 + 16 * w) * DM + 512 + h * 128, lane, 0);
        }
    }
#undef ML_LOADS
#undef ML_LOADX
}
constexpr int MW_SPLIT = 18432;
struct MwItem { const float* W; bf16_t* WT; const float* ks; int ldn, K, k0, n0, mode; };
DI MwItem mw_decode(const Args& a, unsigned char* ws, int it) {
    constexpr int I_GU = 32 * 16 * 16;
    MwItem m; const int sec = it / I_GU, r = it - sec * I_GU, e = r >> 8, q = r & 255;
    if (sec < 2) { m.W = a.in[20 + sec] + (size_t)e * DM * DEXP; m.WT = (bf16_t*)(ws + WS_W1 + (size_t)e * 1024 * DM); m.ks = a.in[15]; m.ldn = DEXP; m.K = DM; m.k0 = 64 * (q >> 4); m.n0 = 32 * (q & 15); }
    else { m.W = a.in[22] + (size_t)e * DEXP * DM; m.WT = (bf16_t*)(ws + WS_W2 + (size_t)e * DM * DEXP); m.ks = nullptr; m.ldn = DM; m.K = DEXP; m.k0 = 64 * (q >> 5); m.n0 = 32 * (q & 31); }
    m.mode = sec; return m;
}
DI void mw_load(const MwItem& m, int lane, f32x4 (&v)[8], float (&ksc)[8]) {
    const int r8 = lane >> 3, c4 = (lane & 7) * 4;
#pragma unroll
    for (int i = 0; i < 8; ++i) { v[i] = *(const f32x4*)(m.W + (size_t)(m.k0 + r8 + 8 * i) * m.ldn + m.n0 + c4); ksc[i] = m.ks ? m.ks[m.k0 + r8 + 8 * i] : 1.f; }
}
DI void mw_store(const MwItem& m, int lane, LAS float* scr, const f32x4 (&v)[8], const float (&ksc)[8]) {
    const int r8 = lane >> 3, c4 = (lane & 7) * 4;
#pragma unroll
    for (int i = 0; i < 8; ++i) { LAS float* d = scr + (r8 + 8 * i) * 33 + c4; d[0] = v[i][0] * ksc[i]; d[1] = v[i][1] * ksc[i]; d[2] = v[i][2] * ksc[i]; d[3] = v[i][3] * ksc[i]; }
    asm volatile("s_waitcnt lgkmcnt(0)" ::: "memory");
    const int c = lane & 7;
#pragma unroll
    for (int j = 0; j < 4; ++j) { const int nl = (lane >> 3) + 8 * j, n = m.n0 + nl; const LAS float* s = scr + (8 * c) * 33 + nl;
        const long orow = (m.mode < 2) ? (long)(n >> 7) * 256 + m.mode * 128 + (n & 127) : n;
        const float sc = (m.mode < 2) ? 32.f : 16.f;
        u32x2 o; o.x = pk4_fp8(s[0 * 33] * sc, s[1 * 33] * sc, s[2 * 33] * sc, s[3 * 33] * sc); o.y = pk4_fp8(s[4 * 33] * sc, s[5 * 33] * sc, s[6 * 33] * sc, s[7 * 33] * sc);
        *(u32x2*)((unsigned char*)m.WT + (size_t)orow * m.K + m.k0 + 8 * c) = o; }
    asm volatile("s_waitcnt lgkmcnt(0)" ::: "memory");
}
DI void moe_weight_items(Frame& F, const Args& a, int wi, int nw, int it_lo, int it_hi) {
    LAS float* scr = (LAS float*)(F.lds + F.wave * 16384);
    const int lane = lane_id(); unsigned char* ws = F.ws;
    const int NIT = it_hi;
    if (it_lo + wi >= NIT) return;
    MwItem cur = mw_decode(a, ws, it_lo + wi); f32x4 v[8]; float ksc[8];
    mw_load(cur, lane, v, ksc);
    for (int it = it_lo + wi; it < NIT; it += nw) {
        const int itn = (it + nw < NIT) ? it + nw : it;
        const MwItem nxt = mw_decode(a, ws, itn); f32x4 vn[8]; float kn[8];
        mw_load(nxt, lane, vn, kn);
        mw_store(cur, lane, scr, v, ksc);
        cur = nxt;
#pragma unroll
        for (int i = 0; i < 8; ++i) { v[i] = vn[i]; ksc[i] = kn[i]; }
    }
}
DI void p2_mixer(Frame& F, const Args& a) {
    const int nret = (F.G + 1) / 2;
    for (int item = F.vcu; item < 256; item += F.G) {
        const int b = item >> 3, h = (item >> 1) & 3;
        if (item & 1) mlstm_item(F, a, b, h, item >> 1); else ret_item(F, a, b, h);
        __syncthreads();
    }
    if ((F.vcu & 1) == 0) {
        const int rc = F.vcu >> 1;
        SchedKV S; S.first = rc; S.step = nret; S.A = (const char*)(F.ws + WS_MEMN); S.B = (const char*)(F.ws + WS_WKV);
        EpiKV8 E{F.ws + WS_KV};
        pg8::gemm_phase<EpiKV8, SchedKV, false, true>(F.lds, DM, S, E, F.wave, 122);
        __syncthreads();
        moe_weight_items(F, a, rc * NWAVES + F.wave, nret * NWAVES, 0, MW_SPLIT);
    }
}

struct EpiP4 {
    static constexpr int NPRE = 0;
    const float* ssq; unsigned char* q;
    DI void operator()(const f32x4 (&acc)[2][2][4][2], const pg8::Unit& u, int wr, int wc, int fr, int fq) const {
        asm volatile("" : "+v"(fr), "+v"(fq));
        const int row0 = u.pm * 256 + wr * 64 + fr, col0 = u.pn * 256 + wc * 32 + 8 * fq;
        f32x4 sp[2][4];
#pragma unroll
        for (int ai = 0; ai < 2; ++ai)
#pragma unroll
            for (int m = 0; m < 4; ++m) sp[ai][m] = *((const f32x4*)(ssq + (size_t)(row0 + ai * 128 + m * 16) * 16) + fq);
        SCHED_FENCE();
#pragma unroll
        for (int ai = 0; ai < 2; ++ai)
#pragma unroll
            for (int m = 0; m < 4; ++m) {
                const int grow = row0 + ai * 128 + m * 16;
                float tot = (sp[ai][m][0] + sp[ai][m][1]) + (sp[ai][m][2] + sp[ai][m][3]); tot += __shfl_xor(tot, 16); tot += __shfl_xor(tot, 32);
                const float rstd = rsqrtf(tot * (1.f / DM) + EPS);
#pragma unroll
                for (int bj = 0; bj < 2; ++bj) { const f32x4 v0 = acc[ai][bj][m][0] * rstd, v1 = acc[ai][bj][m][1] * rstd;
                    u32x2 w; w.x = pk4_fp8(v0[0], v0[1], v0[2], v0[3]); w.y = pk4_fp8(v1[0], v1[1], v1[2], v1[3]);
                    *(u32x2*)(q + (size_t)grow * DM + col0 + bj * 128) = w; }
            }
    }
};
struct EpiP6 {
    static constexpr int NPRE = 0;
    const bf16_t* x1b; bf16_t* x2b; unsigned char* xq8;
    DI void operator()(const f32x4 (&acc)[2][2][4][2], const pg8::Unit& u, int wr, int wc, int fr, int fq) const {
        asm volatile("" : "+v"(fr), "+v"(fq));
        const int row0 = u.pm * 256 + wr * 64 + fr, col0 = u.pn * 256 + wc * 32 + 8 * fq;
        u32x4 rv[2][4][2];
#pragma unroll
        for (int ai = 0; ai < 2; ++ai)
#pragma unroll
            for (int m = 0; m < 4; ++m)
#pragma unroll
                for (int bj = 0; bj < 2; ++bj) rv[ai][m][bj] = *(const u32x4*)(x1b + (size_t)(row0 + ai * 128 + m * 16) * DM + col0 + bj * 128);
        SCHED_FENCE();
#pragma unroll
        for (int ai = 0; ai < 2; ++ai)
#pragma unroll
            for (int m = 0; m < 4; ++m) {
                const int grow = row0 + ai * 128 + m * 16;
#pragma unroll
                for (int bj = 0; bj < 2; ++bj) { const size_t off = (size_t)grow * DM + col0 + bj * 128; const u32x4 r = rv[ai][m][bj];
                    const f32x4 v0 = acc[ai][bj][m][0], v1 = acc[ai][bj][m][1];
                    u32x4 w; w.x = pk2(v0[0] + bflo(r.x), v0[1] + bfhi(r.x)); w.y = pk2(v0[2] + bflo(r.y), v0[3] + bfhi(r.y)); w.z = pk2(v1[0] + bflo(r.z), v1[1] + bfhi(r.z)); w.w = pk2(v1[2] + bflo(r.w), v1[3] + bfhi(r.w));
                    *(u32x4*)(x2b + off) = w;
                    u32x2 w8; w8.x = pk4_fp8(v0[0] + bflo(r.x), v0[1] + bfhi(r.x), v0[2] + bflo(r.y), v0[3] + bfhi(r.y)); w8.y = pk4_fp8(v1[0] + bflo(r.z), v1[1] + bfhi(r.z), v1[2] + bflo(r.w), v1[3] + bfhi(r.w));
                    *(u32x2*)(xq8 + off) = w8; }
            }
    }
};

typedef float f32x16 __attribute__((ext_vector_type(16)));
DI f32x16 mfma32(bf16x8 a, bf16x8 b, f32x16 c) { return __builtin_amdgcn_mfma_f32_32x32x16_bf16(a, b, c, 0, 0, 0); }
constexpr int ARING = 36864;
template <int STRIDE, int ROWB, int NROWS, bool KPERM>
DI void attn_dma5(lptr L, int slot, const bf16_t* src, int w) {
    const int l16 = 16 * lane_id_v();
    const int q0 = l16 / STRIDE, r0 = l16 - q0 * STRIDE;
    constexpr int NCH = NROWS * STRIDE / 1024;
#pragma unroll
    for (int i = 0; i < 5; ++i) {
        int k = w + 8 * i; k = k < NCH ? k : NCH - 1;
        const int Q = (1024 * k) / STRIDE, R = 1024 * k - Q * STRIDE;
        int cb = R + r0, row = Q + q0; if (cb >= STRIDE) { cb -= STRIDE; row += 1; }
        if (KPERM) row = (row & ~12) | ((row & 4) << 1) | ((row & 8) >> 1);
        const unsigned off = (cb < ROWB) ? (unsigned)(row * 256 + (cb >> 1)) : 0u;
        __builtin_amdgcn_global_load_lds((const unsigned*)(src + off), (LAS unsigned*)(L + slot * ARING + 1024 * k), 16, 0, 0);
    }
}
DI bf16x8 fp8x8_to_bf16(u32x2 r) {
    const f32x2 a = __builtin_amdgcn_cvt_pk_f32_fp8((int)r.x, false), b = __builtin_amdgcn_cvt_pk_f32_fp8((int)r.x, true), c = __builtin_amdgcn_cvt_pk_f32_fp8((int)r.y, false), d = __builtin_amdgcn_cvt_pk_f32_fp8((int)r.y, true);
    u32x4 w; w.x = pk2(a[0], a[1]); w.y = pk2(b[0], b[1]); w.z = pk2(c[0], c[1]); w.w = pk2(d[0], d[1]);
    return __builtin_bit_cast(bf16x8, w);
}
template <int DBG> DI void attn_phase(Frame& F) {
    const lptr L = F.lds; const int w = F.wave;
    const unsigned char* q8 = F.ws + WS_Q; const bf16_t* kv = (const bf16_t*)(F.ws + WS_KV); unsigned char* o8 = F.ws + WS_O;
    constexpr int NU = 1024;
    constexpr bool d_nodma = DBG & 1;
    const lptr stg = L + w * 8704;
#define AT_ISSUE(m_) do { if (d_nodma) break; const bf16_t* base_ = kv + ((size_t)bh << 16); \
        if ((m_) < 4) attn_dma5<528, 512, 64, true>(L, ((m_) + 2) & 3, base_ + 64 * (m_) * 256, w); else attn_dma5<144, 128, 256, false>(L, ((m_) + 2) & 3, base_ + ((size_t)NB * 4 << 16) + 64 * ((m_) - 4), w); } while (0)
#define AT_WAIT(m_) do { if ((m_) <= 5) asm volatile("s_waitcnt vmcnt(10)" ::: "memory"); else if ((m_) == 6) asm volatile("s_waitcnt vmcnt(5)" ::: "memory"); else asm volatile("s_waitcnt vmcnt(8)" ::: "memory"); \
        __builtin_amdgcn_s_barrier(); asm volatile("" ::: "memory"); } while (0)
#define AT_QROWS(u_) do { const int u__ = (u_), bh__ = u__ >> 3; const int l__ = lane_id_v(); \
        const unsigned char* src__ = q8 + ((size_t)(bh__ >> 2) * SEQ + (u__ & 7) * 256 + 32 * w + (l__ >> 4)) * DM + (bh__ & 3) * 256 + 16 * (l__ & 15); \
        _Pragma("unroll") for (int it = 0; it < 8; ++it) asm volatile("global_load_dwordx4 %0, %1, off" : "=v"(qt_[it]) : "v"(src__ + (size_t)(4 * it) * DM) : "memory"); } while (0)
    u32x4 qt_[8];
    if (F.vcu < NU) AT_QROWS(F.vcu);
    for (int u = F.vcu; u < NU; u += F.G) {
        const int bh = u >> 3, qt = u & 7, b = bh >> 2, h = bh & 3;
        const int ln_ = lane_id_v();
        const int lr = ln_ & 31, lh = ln_ >> 5;
        const size_t row0 = (size_t)b * SEQ + qt * 256 + 32 * w;
        AT_ISSUE(0); AT_ISSUE(1);
        if (u == F.vcu) asm volatile("s_waitcnt vmcnt(10)" ::: "memory"); else asm volatile("s_waitcnt vmcnt(18)" ::: "memory");
#pragma unroll
        for (int it = 0; it < 8; ++it) *(LAS u32x4*)(stg + (4 * it + (ln_ >> 4)) * 272 + 16 * (ln_ & 15)) = qt_[it];
        bf16x8 qf[16];
#pragma unroll
        for (int ks = 0; ks < 16; ++ks) qf[ks] = fp8x8_to_bf16(*(const LAS u32x2*)(stg + lr * 272 + 16 * ks + 8 * lh));
        asm volatile("s_waitcnt lgkmcnt(0)" ::: "memory");
        __builtin_amdgcn_s_barrier(); asm volatile("" ::: "memory");
        AT_ISSUE(2);
        f32x16 S[8];
        bf16x8 kfA[4], kfB[4];
#define AT_LDS16(d_, a_) asm volatile("ds_read_b128 %0, %1" : "=v"(d_) : "v"(a_) : "memory")
#define AT_LWAIT(n_, f_) asm volatile("s_waitcnt lgkmcnt(" #n_ ")" : "+v"(f_[0]), "+v"(f_[1]), "+v"(f_[2]), "+v"(f_[3]) :: "memory")
#define AT_KREAD(dst_, i_) do { const unsigned kb_ = (unsigned)(size_t)L + ((((i_) >> 3) + 2) & 3) * ARING + lr * 528 + lh * 16 + (((i_) & 7) >> 2) * 32 * 528 + 128 * ((i_) & 3); \
        _Pragma("unroll") for (int jj = 0; jj < 4; ++jj) AT_LDS16(dst_[jj], kb_ + 32 * jj); } while (0)
#define AT_KMMA(src_, i_) do { const int blk_ = 2 * ((i_) >> 3) + (((i_) & 7) >> 2); \
        if (((i_) & 3) == 0) { _Pragma("unroll") for (int i = 0; i < 16; ++i) S[blk_][i] = 0.f; } \
        _Pragma("unroll") for (int jj = 0; jj < 4; ++jj) S[blk_] = mfma32(src_[jj], qf[4 * ((i_) & 3) + jj], S[blk_]); } while (0)
#define AT_KNEXT(dst_, cur_, i_) do { if ((i_) < 32) { if (((i_) & 7) == 0) { AT_LWAIT(0, cur_); AT_WAIT((i_) >> 3); AT_ISSUE(((i_) >> 3) + 3); } AT_KREAD(dst_, (i_)); AT_LWAIT(4, cur_); } else AT_LWAIT(0, cur_); } while (0)
        AT_WAIT(0); AT_ISSUE(3);
        AT_KREAD(kfA, 0);
#pragma unroll
        for (int i2 = 0; i2 < 32; i2 += 2) {
            AT_KNEXT(kfB, kfA, i2 + 1); SCHED_FENCE(); AT_KMMA(kfA, i2); SCHED_FENCE();
            AT_KNEXT(kfA, kfB, i2 + 2); SCHED_FENCE(); AT_KMMA(kfB, i2 + 1); SCHED_FENCE();
        }
        bf16x8 pf[8][2]; float inv;
        {
            float mx = -INFINITY;
#pragma unroll
            for (int blk = 0; blk < 8; ++blk)
#pragma unroll
                for (int i = 0; i < 16; i += 2) mx = fmaxf(mx, fmaxf(S[blk][i], S[blk][i + 1]));
            { auto rr = __builtin_amdgcn_permlane32_swap(__float_as_uint(mx), __float_as_uint(mx), false, false); mx = fmaxf(__uint_as_float(rr[0]), __uint_as_float(rr[1])); }
            float sum = 0.f;
#pragma unroll
            for (int blk = 0; blk < 8; ++blk)
#pragma unroll
                for (int s_ = 0; s_ < 2; ++s_) { float p[8];
#pragma unroll
                    for (int i = 0; i < 8; ++i) p[i] = __builtin_amdgcn_exp2f(S[blk][8 * s_ + i] - mx);
                    sum += ((p[0] + p[1]) + (p[2] + p[3])) + ((p[4] + p[5]) + (p[6] + p[7]));
                    u32x4 pw; pw.x = pk2(p[0], p[1]); pw.y = pk2(p[2], p[3]); pw.z = pk2(p[4], p[5]); pw.w = pk2(p[6], p[7]);
                    pf[blk][s_] = __builtin_bit_cast(bf16x8, pw); }
            { auto rr = __builtin_amdgcn_permlane32_swap(__float_as_uint(sum), __float_as_uint(sum), false, false); sum = __uint_as_float(rr[0]) + __uint_as_float(rr[1]); }
            inv = __builtin_amdgcn_rcpf(sum);
        }
        f32x16 O[8];
#pragma unroll
        for (int eb = 0; eb < 8; ++eb)
#pragma unroll
            for (int i = 0; i < 16; ++i) O[eb][i] = 0.f;
        {
            bf16x8 vfA[4], vfB[4];
#define AT_VREAD(dst_, i_) do { const unsigned vb_ = (unsigned)(size_t)L + ((((i_) >> 3) + 2) & 3) * ARING + lr * 144 + lh * 16 + ((i_) & 7) * 32 * 144; \
        _Pragma("unroll") for (int kk = 0; kk < 4; ++kk) AT_LDS16(dst_[kk], vb_ + 32 * kk); } while (0)
#define AT_VMMA(src_, i_) do { _Pragma("unroll") for (int kk = 0; kk < 4; ++kk) O[(i_) & 7] = mfma32(src_[kk], pf[2 * ((i_) >> 3) + (kk >> 1)][kk & 1], O[(i_) & 7]); } while (0)
#define AT_VNEXT(dst_, cur_, i_) do { if ((i_) < 32) { if (((i_) & 7) == 0) { AT_LWAIT(0, cur_); AT_WAIT(4 + ((i_) >> 3)); \
        if (((i_) >> 3) == 2) { const int un = u + F.G; AT_QROWS(un < NU ? un : u); } }     \
        AT_VREAD(dst_, (i_)); AT_LWAIT(4, cur_); } else AT_LWAIT(0, cur_); } while (0)
            AT_WAIT(4); AT_ISSUE(7);
            AT_VREAD(vfA, 0);
#pragma unroll
            for (int i2 = 0; i2 < 32; i2 += 2) {
                AT_VNEXT(vfB, vfA, i2 + 1); SCHED_FENCE(); AT_VMMA(vfA, i2); SCHED_FENCE();
                AT_VNEXT(vfA, vfB, i2 + 2); SCHED_FENCE(); AT_VMMA(vfB, i2 + 1); SCHED_FENCE();
            }
        }
        __builtin_amdgcn_s_barrier(); asm volatile("" ::: "memory");
        {
            const int ln2 = lane_id_v(); const int r2 = ln2 & 31, h2 = ln2 >> 5; const float sc16 = inv * 16.f;
#pragma unroll
            for (int eb = 0; eb < 8; ++eb)
#pragma unroll
                for (int g = 0; g < 4; ++g) *(LAS unsigned*)(stg + r2 * 272 + 32 * eb + 8 * g + 4 * h2) = pk4_fp8(O[eb][4 * g] * sc16, O[eb][4 * g + 1] * sc16, O[eb][4 * g + 2] * sc16, O[eb][4 * g + 3] * sc16);
            asm volatile("s_waitcnt lgkmcnt(0)" ::: "memory");
#pragma unroll
            for (int it = 0; it < 8; ++it) { const int rr = 4 * it + (ln2 >> 4), ch = ln2 & 15; const u32x4 v = *(const LAS u32x4*)(stg + rr * 272 + 16 * ch);
                *(u32x4*)(o8 + (row0 + rr) * DM + h * 256 + 16 * ch) = v; }
            asm volatile("s_waitcnt lgkmcnt(0)" ::: "memory");
        }
    }
    asm volatile("s_waitcnt vmcnt(0)" ::: "memory");
    __syncthreads();
#undef AT_ISSUE
#undef AT_WAIT
#undef AT_QROWS
#undef AT_KREAD
#undef AT_LDS16
#undef AT_LWAIT
#undef AT_KMMA
#undef AT_KNEXT
#undef AT_VREAD
#undef AT_VMMA
#undef AT_VNEXT
}

typedef unsigned u32x8 __attribute__((ext_vector_type(8)));
DI void mfma8_32(f32x16& acc, const u32x8& a, const u32x8& b, int sa, int sb) {
    asm volatile("s_nop 1\n\tv_mfma_scale_f32_32x32x64_f8f6f4 %0, %1, %2, %0, %3, %4 op_sel_hi:[0,0,0]" : "+v"(acc) : "v"(a), "v"(b), "v"(sa), "v"(sb));
}
DI u32x8 lds32(lptr p) { return __builtin_shufflevector(*(const LAS u32x4*)p, *(const LAS u32x4*)(p + 16), 0, 1, 2, 3, 4, 5, 6, 7); }
template <bool KPERM>
DI void attn8_img_dma(lptr dst, const unsigned char* src, int w) {
    const int l16 = 16 * lane_id_v(); const int q0 = l16 / 272, r0 = l16 - q0 * 272;
#pragma unroll
    for (int i = 0; i < 9; ++i) {
        int k = w + 8 * i; k = k < 68 ? k : 67;
        const int Q = (1024 * k) / 272, R = 1024 * k - Q * 272;
        int cb = R + r0, row = Q + q0; if (cb >= 272) { cb -= 272; row += 1; }
        if (KPERM) row = (row & ~63) | (((row >> 2) & 1) << 5) | (((row >> 5) & 1) << 4) | (((row >> 3) & 3) << 2) | (row & 3);
        const unsigned off = (cb < 256) ? (unsigned)(row * 256 + cb) : 0u;
        __builtin_amdgcn_global_load_lds((const unsigned*)(src + off), (LAS unsigned*)(dst + 1024 * k), 16, 0, 0);
    }
}
DI void attn8_phase(Frame& F) {
    const lptr L = F.lds; const int w = F.wave;
    const unsigned char* q8 = F.ws + WS_Q; const unsigned char* kv8 = F.ws + WS_KV; unsigned char* o8 = F.ws + WS_O;
    constexpr int VIMG = 69632, STG = 139264;
    const lptr stg = L + STG + w * 2944;
    const int SK = 127, SQ = 121, SV = 127, SP = 119;
    u32x4 qt_[8];
#define A8_QROWS(b_, h_, qt__) do { const int l__ = lane_id_v(); \
        const unsigned char* src__ = q8 + ((size_t)(b_) * SEQ + (qt__) * 256 + 32 * w + (l__ >> 4)) * DM + (h_) * 256 + 16 * (l__ & 15); \
        _Pragma("unroll") for (int it = 0; it < 8; ++it) asm volatile("global_load_dwordx4 %0, %1, off" : "=v"(qt_[it]) : "v"(src__ + (size_t)(4 * it) * DM) : "memory"); } while (0)
    for (int p = F.vcu; p < 256; p += F.G) {
        const int bh = p >> 1, b = bh >> 2, h = bh & 3, qt0 = 4 * (p & 1);
        __syncthreads();
        A8_QROWS(b, h, qt0);
        attn8_img_dma<true>(L, kv8 + ((size_t)bh << 16), w);
        attn8_img_dma<false>(L + VIMG, kv8 + ((size_t)(NB * 4 + bh) << 16), w);
        __builtin_amdgcn_s_waitcnt(0);
        __builtin_amdgcn_s_barrier(); asm volatile("" ::: "memory");
#pragma unroll 1
        for (int ui = 0; ui < 4; ++ui) {
            const int ln_ = lane_id_v();
            const int lr = ln_ & 31, lh = ln_ >> 5, c16 = ln_ & 15, rs = ln_ >> 4;
            const size_t row0 = (size_t)b * SEQ + (qt0 + ui) * 256 + 32 * w;
            if (ui > 0) asm volatile("s_waitcnt vmcnt(8)" ::: "memory");
            u32x8 qf[4];
#pragma unroll
            for (int ks = 0; ks < 4; ++ks) {
                if ((c16 >> 2) == ks) {
#pragma unroll
                    for (int it = 0; it < 8; ++it) *(LAS u32x4*)(stg + (4 * it + rs) * 80 + 16 * (c16 & 3)) = qt_[it];
                }
                asm volatile("" ::: "memory");
                qf[ks] = lds32(stg + lr * 80 + 32 * lh);
                asm volatile("" ::: "memory");
            }
            asm volatile("s_waitcnt lgkmcnt(0)" ::: "memory");
            { const int un = ui + 1 < 4 ? ui + 1 : ui; A8_QROWS(b, h, qt0 + un); }
            f32x16 S[8];
            {
                const lptr kb = L + lr * 272 + 32 * lh;
                u32x8 kfA[2], kfB[2];
#define A8_KREAD(d_, i_) do { d_[0] = lds32(kb + ((i_) >> 1) * 32 * 272 + 128 * ((i_) & 1)); d_[1] = lds32(kb + ((i_) >> 1) * 32 * 272 + 128 * ((i_) & 1) + 64); } while (0)
#define A8_KMMA(s_, i_) do { if (((i_) & 1) == 0) { _Pragma("unroll") for (int i = 0; i < 16; ++i) S[(i_) >> 1][i] = 0.f; } \
        mfma8_32(S[(i_) >> 1], s_[0], qf[2 * ((i_) & 1)], SK, SQ); mfma8_32(S[(i_) >> 1], s_[1], qf[2 * ((i_) & 1) + 1], SK, SQ); } while (0)
                A8_KREAD(kfA, 0);
#pragma unroll
                for (int i2 = 0; i2 < 16; i2 += 2) {
                    A8_KREAD(kfB, i2 + 1); SCHED_FENCE(); A8_KMMA(kfA, i2); SCHED_FENCE();
                    if (i2 + 2 < 16) A8_KREAD(kfA, i2 + 2);
                    SCHED_FENCE(); A8_KMMA(kfB, i2 + 1); SCHED_FENCE();
                }
#undef A8_KREAD
#undef A8_KMMA
            }
            asm volatile("s_nop 15\n\ts_nop 15\n\ts_nop 15" : "+v"(S[0]), "+v"(S[1]), "+v"(S[2]), "+v"(S[3]), "+v"(S[4]), "+v"(S[5]), "+v"(S[6]), "+v"(S[7]));
            u32x8 pf[4]; float inv;
            {
                float mx = -INFINITY;
#pragma unroll
                for (int blk = 0; blk < 8; ++blk)
#pragma unroll
                    for (int i = 0; i < 16; i += 2) mx = fmaxf(mx, fmaxf(S[blk][i], S[blk][i + 1]));
                { auto rr = __builtin_amdgcn_permlane32_swap(__float_as_uint(mx), __float_as_uint(mx), false, false); mx = fmaxf(__uint_as_float(rr[0]), __uint_as_float(rr[1])); }
                float sum = 0.f; const float mx8 = mx - 8.f;
#pragma unroll
                for (int blk = 0; blk < 8; ++blk)
#pragma unroll
                    for (int g = 0; g < 4; ++g) { const float p0 = __builtin_amdgcn_exp2f(S[blk][4 * g] - mx8), p1 = __builtin_amdgcn_exp2f(S[blk][4 * g + 1] - mx8), p2 = __builtin_amdgcn_exp2f(S[blk][4 * g + 2] - mx8), p3 = __builtin_amdgcn_exp2f(S[blk][4 * g + 3] - mx8);
                        sum += (p0 + p1) + (p2 + p3);
                        int w_ = 0; w_ = __builtin_amdgcn_cvt_pk_fp8_f32(p0, p1, w_, false); w_ = __builtin_amdgcn_cvt_pk_fp8_f32(p2, p3, w_, true);
                        pf[blk >> 1][4 * (blk & 1) + g] = (unsigned)w_; }
                { auto rr = __builtin_amdgcn_permlane32_swap(__float_as_uint(sum), __float_as_uint(sum), false, false); sum = __uint_as_float(rr[0]) + __uint_as_float(rr[1]); }
                inv = 256.f * __builtin_amdgcn_rcpf(sum);
            }
            f32x16 O[8];
#pragma unroll
            for (int eb = 0; eb < 8; ++eb)
#pragma unroll
                for (int i = 0; i < 16; ++i) O[eb][i] = 0.f;
            {
                const lptr vb = L + VIMG + lr * 272 + 32 * lh;
                u32x8 vfA[2], vfB[2];
#define A8_VREAD(d_, i_) do { d_[0] = lds32(vb + (2 * ((i_) & 3)) * 32 * 272 + 64 * ((i_) >> 2)); d_[1] = lds32(vb + (2 * ((i_) & 3) + 1) * 32 * 272 + 64 * ((i_) >> 2)); } while (0)
#define A8_VMMA(s_, i_) do { mfma8_32(O[2 * ((i_) & 3)], s_[0], pf[(i_) >> 2], SV, SP); mfma8_32(O[2 * ((i_) & 3) + 1], s_[1], pf[(i_) >> 2], SV, SP); } while (0)
                A8_VREAD(vfA, 0);
#pragma unroll
                for (int i2 = 0; i2 < 16; i2 += 2) {
                    A8_VREAD(vfB, i2 + 1); SCHED_FENCE(); A8_VMMA(vfA, i2); SCHED_FENCE();
                    if (i2 + 2 < 16) A8_VREAD(vfA, i2 + 2);
                    SCHED_FENCE(); A8_VMMA(vfB, i2 + 1); SCHED_FENCE();
                }
#undef A8_VREAD
#undef A8_VMMA
            }
            asm volatile("s_nop 15\n\ts_nop 15\n\ts_nop 15" : "+v"(O[0]), "+v"(O[1]), "+v"(O[2]), "+v"(O[3]), "+v"(O[4]), "+v"(O[5]), "+v"(O[6]), "+v"(O[7]));
            {
                const float sc16 = inv * 16.f; u32x4 ot[8];
#pragma unroll
                for (int it = 0; it < 8; ++it) ot[it] = (u32x4){0u, 0u, 0u, 0u};
#pragma unroll
                for (int ps = 0; ps < 4; ++ps) {
#pragma unroll
                    for (int e2 = 0; e2 < 2; ++e2)
#pragma unroll
                        for (int g = 0; g < 4; ++g) { const f32x16& o = O[2 * ps + e2];
                            *(LAS unsigned*)(stg + lr * 80 + 32 * e2 + 8 * g + 4 * lh) = pk4_fp8(o[4 * g] * sc16, o[4 * g + 1] * sc16, o[4 * g + 2] * sc16, o[4 * g + 3] * sc16); }
                    asm volatile("" ::: "memory");
                    if ((c16 >> 2) == ps) {
#pragma unroll
                        for (int it = 0; it < 8; ++it) ot[it] = *(const LAS u32x4*)(stg + (4 * it + rs) * 80 + 16 * (c16 & 3));
                    }
                    asm volatile("" ::: "memory");
                }
#pragma unroll
                for (int it = 0; it < 8; ++it) *(u32x4*)(o8 + (row0 + 4 * it + rs) * DM + h * 256 + 16 * c16) = ot[it];
            }
        }
    }
    asm volatile("s_waitcnt vmcnt(0)" ::: "memory");
    __syncthreads();
#undef A8_QROWS
}

DI void p7_router(Frame& F, const Args& a) {
    const lptr L = F.lds; const int w = F.wave;
    constexpr int RW_STRIDE = 2064, RW_HALF = 37 * RW_STRIDE, RW_HIST = 2 * RW_HALF;
    LAS unsigned* hist = (LAS unsigned*)(L + RW_HIST); LAS unsigned* base = hist + 32;
    const bf16_t* x2 = (const bf16_t*)(F.ws + WS_X2B); const bf16_t* whi = (const bf16_t*)(F.ws + WS_WR); const bf16_t* wlo = whi + 48 * 1024;
    {
        const int t0 = F.wave * 64 + lane_id();
        for (int i = t0; i < 37 * 128; i += NTHR) { const int r = i >> 7, c = i & 127; const int srow = r < 32 ? r : (r < 36 ? 32 + 4 * (r - 32) : -1);
            u32x4 vh = {0u, 0u, 0u, 0u}, vl = {0u, 0u, 0u, 0u};
            if (srow >= 0) { vh = *(const u32x4*)(whi + (size_t)srow * 1024 + c * 8); vl = *(const u32x4*)(wlo + (size_t)srow * 1024 + c * 8); }
            *(LAS u32x4*)(L + r * RW_STRIDE + c * 16) = vh; *(LAS u32x4*)(L + RW_HALF + r * RW_STRIDE + c * 16) = vl; }
        __syncthreads();
    }
    unsigned* gcnt = (unsigned*)(F.ws + WS_CTL) + CW_CNT;
    int* rowid = (int*)(F.ws + WS_ROWID); f32x2* rowf = (f32x2*)(F.ws + WS_ROWF);
    const float* b_group = a.in[17]; const float* b_router = a.in[19];
    for (int blk = F.vcu; blk < NT / 256; blk += F.G) {
        int tid = F.wave * 64 + lane_id(); asm volatile("" : "+v"(tid));
        const int lane = tid & 63, fr = lane & 15, fq = lane >> 4;
        if (tid < 32) hist[tid] = 0u;
        __syncthreads();
        const size_t tok0 = (size_t)blk * 256 + 32 * w;
        f32x4 acc[2][3]; float ssq[2] = {0.f, 0.f};
#pragma unroll
        for (int rg = 0; rg < 2; ++rg)
#pragma unroll
            for (int cb = 0; cb < 3; ++cb) acc[rg][cb] = (f32x4){0.f, 0.f, 0.f, 0.f};
#pragma unroll 4
        for (int ks = 0; ks < 32; ++ks) {
            bf16x8 xf[2];
#pragma unroll
            for (int rg = 0; rg < 2; ++rg) { xf[rg] = *(const bf16x8*)(x2 + (tok0 + 16 * rg + fr) * DM + 32 * ks + 8 * fq); const u32x4 xu = __builtin_bit_cast(u32x4, xf[rg]);
                const float e0 = bflo(xu.x), e1 = bfhi(xu.x), e2 = bflo(xu.y), e3 = bfhi(xu.y), e4 = bflo(xu.z), e5 = bfhi(xu.z), e6 = bflo(xu.w), e7 = bfhi(xu.w);
                ssq[rg] += (e0 * e0 + e1 * e1) + (e2 * e2 + e3 * e3) + (e4 * e4 + e5 * e5) + (e6 * e6 + e7 * e7); }
#pragma unroll
            for (int cb = 0; cb < 3; ++cb) { const int lrow = cb < 2 ? 16 * cb + fr : ((fr & 3) == 0 ? 32 + (fr >> 2) : 36); const lptr wp = L + lrow * RW_STRIDE + (32 * ks + 8 * fq) * 2; const bf16x8 wh = lds16(wp), wl = lds16(wp + RW_HALF);
#pragma unroll
                for (int rg = 0; rg < 2; ++rg) { acc[rg][cb] = mfma16(wh, xf[rg], acc[rg][cb]); acc[rg][cb] = mfma16(wl, xf[rg], acc[rg][cb]); } }
        }
        int e1_[2], e2_[2]; unsigned r1_[2], r2_[2]; float w1_[2], w2_[2], rs_[2]; bool win_[2];
#pragma unroll
        for (int rg = 0; rg < 2; ++rg) {
            float sq = ssq[rg]; sq += __shfl_xor(sq, 16); sq += __shfl_xor(sq, 32);
            const float rstd = rsqrtf(sq * (1.f / DM) + EPS);
            float l[8];
#pragma unroll
            for (int i = 0; i < 4; ++i) { l[i] = acc[rg][0][i] * rstd + b_router[8 * fq + i]; l[4 + i] = acc[rg][1][i] * rstd + b_router[8 * fq + 4 + i]; }
            const float gl = acc[rg][2][0] * rstd + b_group[fq];
            const float g0 = __shfl(gl, fr), g1 = __shfl(gl, fr + 16), g2 = __shfl(gl, fr + 32), g3 = __shfl(gl, fr + 48);
            int gsel = 0; float gmax = g0;
            if (g1 > gmax) { gmax = g1; gsel = 1; } if (g2 > gmax) { gmax = g2; gsel = 2; } if (g3 > gmax) { gmax = g3; gsel = 3; }
            const float gw = 1.f / (__expf(g0 - gmax) + __expf(g1 - gmax) + __expf(g2 - gmax) + __expf(g3 - gmax));
            int i1 = 0; float m1 = l[0];
#pragma unroll
            for (int i = 1; i < 8; ++i) if (l[i] > m1) { m1 = l[i]; i1 = i; }
            int i2 = -1; float m2 = -INFINITY;
#pragma unroll
            for (int i = 0; i < 8; ++i) if (i != i1 && l[i] > m2) { m2 = l[i]; i2 = i; }
            const float p2 = __expf(m2 - m1);
            win_[rg] = (fq == gsel); e1_[rg] = 8 * fq + i1; e2_[rg] = 8 * fq + i2; w1_[rg] = gw / (1.f + p2); w2_[rg] = gw * p2 / (1.f + p2); rs_[rg] = rstd;
            r1_[rg] = 0u; r2_[rg] = 0u;
            if (win_[rg]) { r1_[rg] = atomicAdd((unsigned*)&hist[e1_[rg]], 1u); r2_[rg] = atomicAdd((unsigned*)&hist[e2_[rg]], 1u); }
        }
        __syncthreads();
        if (tid < 32) base[tid] = atomicAdd(&gcnt[tid], hist[tid]);
        __syncthreads();
#pragma unroll
        for (int rg = 0; rg < 2; ++rg) if (win_[rg]) {
            const int tok = (int)tok0 + 16 * rg + fr;
            const size_t s1 = (size_t)e1_[rg] * CAPE + base[e1_[rg]] + r1_[rg], s2 = (size_t)e2_[rg] * CAPE + base[e2_[rg]] + r2_[rg];
            rowid[s1] = 2 * tok; rowf[s1] = (f32x2){rs_[rg], w1_[rg]}; rowid[s2] = 2 * tok + 1; rowf[s2] = (f32x2){rs_[rg], w2_[rg]};
        }
        __syncthreads();
    }
}
DI void moe_setup(Frame& F) {
    LAS int* tb = (LAS int*)(F.lds + MISC_OFF); LAS int* cn = tb + 40;
    const unsigned* gcnt = (const unsigned*)(F.ws + WS_CTL) + CW_CNT;
    const int tid = F.wave * 64 + lane_id();
    __syncthreads();
    if (tid < 32) cn[tid] = (int)__hip_atomic_load(gcnt + tid, __ATOMIC_RELAXED, __HIP_MEMORY_SCOPE_AGENT);
    __syncthreads();
    if (tid == 0) { int acc = 0; for (int e = 0; e < 32; ++e) { tb[e] = acc; acc += (cn[e] + 255) >> 8; } tb[32] = acc; }
    __syncthreads();
}
struct SchedMoE {
    LAS const int* tb; LAS const int* cn; int G, vcu, K, gather; const char* A; const char* Bbase; size_t b_estride, b_tstride; const int* rowid;
    DI bool next(int i, pg8::Unit& u) const {
        const int L = i * G + vcu; if (L >= tb[32] * 4) return false;
        const int t = L >> 2, pn = L & 3; int e = 0;
#pragma unroll
        for (int j = 1; j < 32; ++j) e += (tb[j] <= t) ? 1 : 0;
        u.pm = t; u.pn = pn; u.tag = e; u.aux = t - tb[e];
        u.B = Bbase + (size_t)e * b_estride + (size_t)pn * b_tstride;
        u.A = gather ? A : A + (size_t)t * 256 * K;
        return true;
    }
    DI unsigned arow(const pg8::Unit& u, int row) const { const int slot = u.aux * 256 + row; return slot < cn[u.tag] ? (unsigned)(rowid[(size_t)u.tag * CAPE + slot] >> 1) : 0u; }
    DI const int* arow_ptr(const pg8::Unit& u, int row) const { return rowid + ((size_t)u.tag * CAPE + u.aux * 256 + row); }
    DI int rows_left(const pg8::Unit& u) const { return cn[u.tag] - u.aux * 256; }
};
struct EpiM1 {
    const f32x2* rowf; bf16_t* hid;
    static constexpr int NPRE = 8;
    DI void prefetch(unsigned (&pre)[8], const pg8::Unit& u, int wr, int fr) const {
        asm volatile("" : "+v"(fr));
#pragma unroll
        for (int ai = 0; ai < 2; ++ai)
#pragma unroll
            for (int m = 0; m < 4; ++m) asm volatile("global_load_dword %0, %1, off" : "=v"(pre[ai * 4 + m]) : "v"((const float*)(rowf + ((size_t)u.tag * CAPE + u.aux * 256 + ai * 128 + wr * 64 + m * 16 + fr))) : "memory");
    }
    DI void operator()(const f32x4 (&acc)[2][2][4][2], const pg8::Unit& u, int wr, int wc, int fr, int fq, const unsigned (&pre)[8]) const {
        asm volatile("" : "+v"(fr), "+v"(fq));
        float rs[2][4];
#pragma unroll
        for (int ai = 0; ai < 2; ++ai)
#pragma unroll
            for (int m = 0; m < 4; ++m) rs[ai][m] = __uint_as_float(pre[ai * 4 + m]);
#pragma unroll
        for (int ai = 0; ai < 2; ++ai)
#pragma unroll
            for (int m = 0; m < 4; ++m) {
                const int row = ai * 128 + wr * 64 + m * 16 + fr; const float rstd = rs[ai][m];
                const f32x4 g0 = acc[ai][0][m][0] * rstd, g1 = acc[ai][0][m][1] * rstd, u0 = acc[ai][1][m][0] * rstd, u1 = acc[ai][1][m][1] * rstd;
                u32x2 w; w.x = pk4_fp8(silu_f(g0[0]) * u0[0], silu_f(g0[1]) * u0[1], silu_f(g0[2]) * u0[2], silu_f(g0[3]) * u0[3]);
                w.y = pk4_fp8(silu_f(g1[0]) * u1[0], silu_f(g1[1]) * u1[1], silu_f(g1[2]) * u1[2], silu_f(g1[3]) * u1[3]);
                *(u32x2*)((unsigned char*)hid + ((size_t)u.pm * 256 + row) * DEXP + u.pn * 128 + wc * 32 + 8 * fq) = w;
            }
    }
};
struct EpiM2 {
    LAS const int* cn; const int* rowid; const f32x2* rowf; bf16_t* ybuf;
    static constexpr int NPRE = 16;
    DI void prefetch(unsigned (&pre)[16], const pg8::Unit& u, int wr, int fr) const {
        asm volatile("" : "+v"(fr));
#pragma unroll
        for (int ai = 0; ai < 2; ++ai)
#pragma unroll
            for (int m = 0; m < 4; ++m) { const size_t si = (size_t)u.tag * CAPE + u.aux * 256 + ai * 128 + wr * 64 + m * 16 + fr;
                asm volatile("global_load_dword %0, %1, off" : "=v"(pre[ai * 4 + m]) : "v"(rowid + si) : "memory");
                asm volatile("global_load_dword %0, %1, off" : "=v"(pre[8 + ai * 4 + m]) : "v"((const float*)(rowf + si) + 1) : "memory"); }
    }
    DI void operator()(const f32x4 (&acc)[2][2][4][2], const pg8::Unit& u, int wr, int wc, int fr, int fq, const unsigned (&pre)[16]) const {
        asm volatile("" : "+v"(fr), "+v"(fq));
        int ids[2][4]; float wgs[2][4];
#pragma unroll
        for (int ai = 0; ai < 2; ++ai)
#pragma unroll
            for (int m = 0; m < 4; ++m) { ids[ai][m] = (int)pre[ai * 4 + m]; wgs[ai][m] = __uint_as_float(pre[8 + ai * 4 + m]); }
        const int cnt = cn[u.tag];
#pragma unroll
        for (int ai = 0; ai < 2; ++ai)
#pragma unroll
            for (int m = 0; m < 4; ++m) {
                const int row = ai * 128 + wr * 64 + m * 16 + fr, slot = u.aux * 256 + row;
                if (slot < cnt) {
                    const int id = ids[ai][m]; const float wg = wgs[ai][m];
#pragma unroll
                    for (int bj = 0; bj < 2; ++bj) { const f32x4 v0 = acc[ai][bj][m][0] * (wg * 16.f), v1 = acc[ai][bj][m][1] * (wg * 16.f);
                        u32x2 w; w.x = pk4_fp8(v0[0], v0[1], v0[2], v0[3]); w.y = pk4_fp8(v1[0], v1[1], v1[2], v1[3]);
                        *(u32x2*)((unsigned char*)ybuf + (size_t)id * DM + u.pn * 256 + bj * 128 + wc * 32 + 8 * fq) = w; }
                }
            }
    }
};

DI void p_final(Frame& F, const Args& a, size_t src_off) {
    const int gw = F.vcu * NWAVES + F.wave, NGW = F.G * NWAVES, lane = lane_id_v();
    const bf16_t* x2 = (const bf16_t*)(F.ws + src_off); const unsigned char* yb = F.ws + WS_YBUF;
    const float* g = a.in[23];
    f32x4 gv[4];
#pragma unroll
    for (int j = 0; j < 4; ++j) gv[j] = *((const f32x4*)g + lane * 2 + (j & 1) + 128 * (j >> 1));
    u32x4 xaA[2], xaB[2], xaC[2]; u32x2 y0A[2], y0B[2], y0C[2], y1A[2], y1B[2], y1C[2];
#define PF_LOAD(S, row_) do { const int r_ = (row_) < NT ? (row_) : gw; _Pragma("unroll") for (int hlf = 0; hlf < 2; ++hlf) { \
        asm volatile("global_load_dwordx4 %0, %1, off" : "=v"(xa##S[hlf]) : "v"((const u32x4*)(x2 + (size_t)r_ * DM) + lane + 64 * hlf) : "memory"); \
        asm volatile("global_load_dwordx2 %0, %1, off" : "=v"(y0##S[hlf]) : "v"((const u32x2*)(yb + (size_t)(2 * r_) * DM) + lane + 64 * hlf) : "memory"); \
        asm volatile("global_load_dwordx2 %0, %1, off" : "=v"(y1##S[hlf]) : "v"((const u32x2*)(yb + (size_t)(2 * r_ + 1) * DM) + lane + 64 * hlf) : "memory"); } } while (0)
#define PF_WAIT(n_, S) asm volatile("s_waitcnt vmcnt(" #n_ ")" : "+v"(xa##S[0]), "+v"(xa##S[1]), "+v"(y0##S[0]), "+v"(y0##S[1]), "+v"(y1##S[0]), "+v"(y1##S[1]) :: "memory")
#define PF_Y8(q, W, HI) { const f32x2 f0 = __builtin_amdgcn_cvt_pk_f32_fp8((int)a0.W, HI), f1 = __builtin_amdgcn_cvt_pk_f32_fp8((int)a1.W, HI); \
        t[2 * q] += (f0[0] + f1[0]) * 0.0625f; t[2 * q + 1] += (f0[1] + f1[1]) * 0.0625f; }
#define PF_DO(S, row_) do { const int ro_ = (row_) < NT ? (row_) : gw; float v[16]; \
        _Pragma("unroll") for (int hlf = 0; hlf < 2; ++hlf) { const u32x4 xv = xa##S[hlf]; \
            float t[8] = {bflo(xv.x), bfhi(xv.x), bflo(xv.y), bfhi(xv.y), bflo(xv.z), bfhi(xv.z), bflo(xv.w), bfhi(xv.w)}; \
            { const u32x2 a0 = y0##S[hlf], a1 = y1##S[hlf]; PF_Y8(0, x, false) PF_Y8(1, x, true) PF_Y8(2, y, false) PF_Y8(3, y, true) } \
            _Pragma("unroll") for (int j = 0; j < 8; ++j) v[8 * hlf + j] = t[j]; } \
        float s = 0.f; _Pragma("unroll") for (int j = 0; j < 16; ++j) s += v[j] * v[j]; \
        const float rstd = rsqrtf(wave_sum(s) * (1.f / DM) + EPS); \
        f32x4* o = (f32x4*)(a.out + (size_t)ro_ * DM); \
        _Pragma("unroll") for (int j = 0; j < 4; ++j) { f32x4 r; r.x = v[4 * j] * rstd * gv[j].x; r.y = v[4 * j + 1] * rstd * gv[j].y; r.z = v[4 * j + 2] * rstd * gv[j].z; r.w = v[4 * j + 3] * rstd * gv[j].w; \
            o[lane * 2 + (j & 1) + 128 * (j >> 1)] = r; } } while (0)
    PF_LOAD(A, gw); PF_LOAD(B, gw + NGW); PF_LOAD(C, gw + 2 * NGW);
    PF_WAIT(12, A); PF_DO(A, gw); PF_LOAD(A, gw + 3 * NGW);
    PF_WAIT(16, B); PF_DO(B, gw + NGW); PF_LOAD(B, gw + 4 * NGW);
    for (int m = gw + 2 * NGW; m < NT; m += 3 * NGW) {
        PF_WAIT(20, C); PF_DO(C, m); PF_LOAD(C, m + 3 * NGW);
        PF_WAIT(20, A); PF_DO(A, m + NGW); PF_LOAD(A, m + 4 * NGW);
        PF_WAIT(20, B); PF_DO(B, m + 2 * NGW); PF_LOAD(B, m + 5 * NGW);
    }
#undef PF_LOAD
#undef PF_WAIT
#undef PF_Y8
#undef PF_DO
}

__global__ void __launch_bounds__(NTHR, 2) fwd_megakernel(Args args) {
    extern __shared__ __attribute__((aligned(16))) unsigned char lds_raw[];
    Frame F;
    F.lds = (lptr)lds_raw; F.wave = __builtin_amdgcn_readfirstlane((int)threadIdx.x >> 6);
    F.G = gridDim.x; F.bx = blockIdx.x; F.vcu = (F.G % 8 == 0) ? (F.bx % 8) * (F.G / 8) + F.bx / 8 : F.bx;
    F.ws = args.ws;
    const int lo = args.ph_lo, hi = args.ph_hi;
    const bool leader = (F.wave == 0) && (lane_id() == 0);
    { volatile LAS unsigned* st = (volatile LAS unsigned*)(F.lds + MISC_OFF + 768); if (leader) { st[0] = 0u; st[1] = 0u; } }
    __syncthreads();
    const XcdBarrier gbar = xcd_barrier_post((unsigned*)(F.ws + WS_CTL) + CW_BAR, (volatile LAS unsigned*)(F.lds + MISC_OFF + 768), leader);
#define IN(k) (lo <= (k) && (k) < hi)
#define SEAM(k) do { if (IN(k) && hi > (k) + 1) xcd_barrier(gbar, (F.wave == 0) && (lane_id() == 0)); } while (0)
    if (IN(0)) { p0_prologue(F, args); __syncthreads(); moe_weight_items(F, args, F.vcu * NWAVES + F.wave, F.G * NWAVES, MW_SPLIT, 3 * 32 * 16 * 16); }
    SEAM(0);
    if (IN(1)) {
        SchedDense S; S.o.init(NT, NP1, F.G, F.bx); S.A = (const char*)(F.ws + WS_XN0); S.B = (const char*)(F.ws + WS_WIN); S.K = DM;
        EpiP1 E{(bf16_t*)(F.ws + WS_PROJ), (bf16_t*)(F.ws + WS_KV), (const f32x4*)(F.ws + WS_ROPE)};
        pg8::gemm_phase<EpiP1, SchedDense, false>(F.lds, 2 * DM, S, E, F.wave);
    }
    SEAM(1);
    if (IN(2)) { p2_mixer(F, args); }
    SEAM(2);
    if (IN(3)) {
        SchedDense S; S.o.init(NT, DM, F.G, F.bx); S.A = (const char*)(F.ws + WS_MIX); S.B = (const char*)(F.ws + WS_WOUT); S.K = DM;
        EpiP3 E{(const bf16_t*)(F.ws + WS_XN0), (const float*)(F.ws + WS_RMS), (bf16_t*)(F.ws + WS_X1B), (float*)(F.ws + WS_SSQ1), F.ws + WS_X1Q8};
        pg8::gemm_phase<EpiP3, SchedDense, false>(F.lds, 2 * DM, S, E, F.wave);
    }
    SEAM(3);
    if (IN(4)) {
        SchedDense S; S.o.init(NT, DM, F.G, F.bx); S.A = (const char*)(F.ws + WS_X1Q8); S.B = (const char*)(F.ws + WS_WQ); S.K = DM / 2;
        EpiP4 E{(const float*)(F.ws + WS_SSQ1), F.ws + WS_Q};
        pg8::gemm_phase<EpiP4, SchedDense, false, true>(F.lds, DM, S, E, F.wave, 124);
    }
    SEAM(4);
    if (IN(5)) { attn8_phase(F); }
    SEAM(5);
    if (IN(6)) {
        SchedDense S; S.o.init(NT, DM, F.G, F.bx); S.A = (const char*)(F.ws + WS_O); S.B = (const char*)(F.ws + WS_WO); S.K = DM / 2;
        EpiP6 E{(const bf16_t*)(F.ws + WS_X1B), (bf16_t*)(F.ws + WS_X2B), F.ws + WS_XQ8};
        pg8::gemm_phase<EpiP6, SchedDense, false, true>(F.lds, DM, S, E, F.wave, 122, 123);
    }
    SEAM(6);
    if (IN(7)) { p7_router(F, args); }
    SEAM(7);
    if (IN(8)) {
        moe_setup(F);
        SchedMoE S; S.tb = (LAS const int*)(F.lds + MISC_OFF); S.cn = S.tb + 40; S.G = F.G; S.vcu = F.vcu; S.K = DM; S.gather = 1;
        S.A = (const char*)(F.ws + WS_XQ8); S.Bbase = (const char*)(F.ws + WS_W1); S.b_estride = (size_t)1024 * DM; S.b_tstride = (size_t)256 * DM; S.rowid = (const int*)(F.ws + WS_ROWID);
        EpiM1 E{(const f32x2*)(F.ws + WS_ROWF), (bf16_t*)(F.ws + WS_HID)};
        pg8::gemm_phase<EpiM1, SchedMoE, true, true>(F.lds, DM, S, E, F.wave, 122);
    }
    SEAM(8);
    if (IN(9)) {
        moe_setup(F);
        SchedMoE S; S.tb = (LAS const int*)(F.lds + MISC_OFF); S.cn = S.tb + 40; S.G = F.G; S.vcu = F.vcu; S.K = DEXP; S.gather = 0;
        S.A = (const char*)(F.ws + WS_HID); S.Bbase = (const char*)(F.ws + WS_W2); S.b_estride = (size_t)DM * DEXP; S.b_tstride = (size_t)256 * DEXP; S.rowid = (const int*)(F.ws + WS_ROWID);
        EpiM2 E{S.cn, (const int*)(F.ws + WS_ROWID), (const f32x2*)(F.ws + WS_ROWF), (bf16_t*)(F.ws + WS_YBUF)};
        pg8::gemm_phase<EpiM2, SchedMoE, false, true>(F.lds, DEXP, S, E, F.wave, 123);
    }
    SEAM(9);
    if (IN(10)) { p_final(F, args, WS_X2B); }
#undef IN
#undef SEAM
}


#if DUPK == 55
__global__ void __launch_bounds__(NTHR, 2) attn_probe_kernel(Args args) {
    extern __shared__ __attribute__((aligned(16))) unsigned char lds_raw[];
    Frame F;
    F.lds = (lptr)lds_raw; F.wave = __builtin_amdgcn_readfirstlane((int)threadIdx.x >> 6);
    F.G = gridDim.x; F.bx = blockIdx.x; F.vcu = (F.G % 8 == 0) ? (F.bx % 8) * (F.G / 8) + F.bx / 8 : F.bx;
    F.ws = args.ws;
    attn_phase<DBGV>(F);
}
#endif
extern "C" void kernel_launch(void* const* d_in, const int* in_sizes, int n_in, void* d_out, int out_size, void* d_ws, size_t ws_size, hipStream_t stream) {
    static int grid = 0;
    if (grid == 0) {
        if (n_in != 24 || out_size != NT * DM || ws_size < WS_END) { fprintf(stderr, "kernel_launch: unexpected shapes (n_in %d out %d ws %zu)\n", n_in, out_size, ws_size); grid = -1; return; }
        int dev = 0, cus = 0, per_cu = 0;
        hipGetDevice(&dev); hipDeviceGetAttribute(&cus, hipDeviceAttributeMultiprocessorCount, dev);
        hipFuncSetAttribute((const void*)fwd_megakernel, hipFuncAttributeMaxDynamicSharedMemorySize, LDS_BYTES);
        hipOccupancyMaxActiveBlocksPerMultiprocessor(&per_cu, (const void*)fwd_megakernel, NTHR, LDS_BYTES);
        if (per_cu < 1) { fprintf(stderr, "kernel_launch: occupancy query says %d blocks/CU\n", per_cu); per_cu = 1; }
        (void)hipGetLastError();
        grid = cus * 1;
        if (grid > 256) grid = 256;
    }
    if (grid < 0) return;
    hipMemsetAsync((char*)d_ws + WS_CTL, 0, CTL_ZERO_BYTES, stream);
    Args a{};
    for (int i = 0; i < 24; ++i) a.in[i] = (const float*)d_in[i];
    a.out = (float*)d_out; a.ws = (unsigned char*)d_ws; a.ph_lo = 0; a.ph_hi = 11; a.dupk = DUPK; a.dbg = 0;
    void* kargs[] = {&a};
    hipError_t e = hipLaunchCooperativeKernel((const void*)fwd_megakernel, dim3(grid), dim3(NTHR), kargs, LDS_BYTES, stream);
    if (e != hipSuccess) fprintf(stderr, "cooperative launch failed: %s (grid %d)\n", hipGetErrorString(e), grid);
#if DUPK == 55
    { static bool once = false; if (!once) { hipFuncSetAttribute((const void*)attn_probe_kernel, hipFuncAttributeMaxDynamicSharedMemorySize, LDS_BYTES); once = true; }
      void* pa[] = {&a}; hipLaunchCooperativeKernel((const void*)attn_probe_kernel, dim3(grid), dim3(NTHR), pa, LDS_BYTES, stream); }
#elif DUPK >= 0
    hipMemsetAsync((char*)d_ws + WS_CTL + 4096 * 4, 0, 16384, stream);
    a.ph_lo = DUPK; a.ph_hi = DUPK + 1; a.dbg = DBGV;
    e = hipLaunchCooperativeKernel((const void*)fwd_megakernel, dim3(grid), dim3(NTHR), kargs, LDS_BYTES, stream);
#endif
}
```

```cpp
#include <hip/hip_runtime.h>
#include <hip/hip_cooperative_groups.h>
#include <cstdio>
#include <cstdint>
namespace cg = cooperative_groups;
#ifndef DUPK
#define DUPK (-1)
#endif
#ifndef DBGV
#define DBGV 0
#endif

#define DI __device__ __forceinline__
#define LAS __attribute__((address_space(3)))
typedef unsigned short bf16_t;
typedef short bf16x8 __attribute__((ext_vector_type(8)));
typedef short s16x4 __attribute__((ext_vector_type(4)));
typedef float f32x4 __attribute__((ext_vector_type(4)));
typedef float f32x2 __attribute__((ext_vector_type(2)));
typedef unsigned u32x4 __attribute__((ext_vector_type(4)));
typedef unsigned u32x2 __attribute__((ext_vector_type(2)));
typedef __bf16 bf16x2_t __attribute__((ext_vector_type(2)));
typedef LAS unsigned char* lptr;

constexpr int NT = 65536, DM = 1024, SEQ = 2048, NB = 32;
constexpr int INW = 3592, NP1 = 3584;
constexpr int MEMT = 8192;
constexpr int NEXP = 32, DEXP = 512;
constexpr int CAPE = 131072;
constexpr float EPS = 1e-6f;
constexpr int NWAVES = 8, NTHR = 512;

constexpr size_t MiB = 1u << 20;
constexpr size_t WS_CTL = 0, CTL_ZERO_BYTES = 64 * 1024;
constexpr size_t WS_WIN  = 1 * MiB;
constexpr size_t WS_WOUT = 8 * MiB;
constexpr size_t WS_WQ   = 10 * MiB;
constexpr size_t WS_WKV  = 12 * MiB;
constexpr size_t WS_WO   = 16 * MiB;
constexpr size_t WS_W1   = 18 * MiB;
constexpr size_t WS_W2   = 82 * MiB;
constexpr size_t WS_WR   = 114 * MiB;
constexpr size_t WS_ROPE = 115 * MiB;
constexpr size_t WS_GATES = 116 * MiB;
constexpr size_t WS_SSQ1 = 118 * MiB;
constexpr size_t WS_ROWID = 122 * MiB;
constexpr size_t WS_ROWF = 138 * MiB;
constexpr size_t WS_MEMN = 170 * MiB;
constexpr size_t WS_KV   = 186 * MiB;
constexpr size_t WS_A    = 218 * MiB;
constexpr size_t WS_B    = 346 * MiB;
constexpr size_t WS_C    = 794 * MiB;
constexpr size_t WS_XN0 = WS_A, WS_X1B = WS_A;
constexpr size_t WS_PROJ = WS_B, WS_Q = WS_B, WS_O = WS_B + 128 * MiB, WS_X2B = WS_B + 256 * MiB, WS_YBUF = WS_B;
constexpr size_t WS_MIX = WS_C, WS_HID = WS_C;
constexpr size_t WS_X1Q8 = WS_B + 128 * MiB;
constexpr size_t WS_XQ8 = WS_B + 384 * MiB;
constexpr size_t WS_GARR = 930 * MiB;
constexpr size_t WS_RMS = 934 * MiB;
constexpr size_t WS_END = 935 * MiB;
constexpr int CW_CNT = 64;
constexpr int CW_BAR = 4096;

constexpr int LDS_BYTES = 163840;
constexpr int MISC_OFF = 162816;

DI int lane_id() { return (int)__builtin_amdgcn_mbcnt_hi(~0u, __builtin_amdgcn_mbcnt_lo(~0u, 0u)); }
DI int lane_id_v() { int l; asm volatile("v_mbcnt_lo_u32_b32 %0, -1, 0\n\tv_mbcnt_hi_u32_b32 %0, -1, %0" : "=v"(l)); return l; }
DI float bf2f(unsigned short u) { return __uint_as_float((unsigned)u << 16); }
DI float bflo(unsigned u) { return __uint_as_float(u << 16); }
DI float bfhi(unsigned u) { return __uint_as_float(u & 0xffff0000u); }
DI unsigned pk2(float lo, float hi) { f32x2 v = {lo, hi}; bf16x2_t b = __builtin_convertvector(v, bf16x2_t); return __builtin_bit_cast(unsigned, b); }
DI float wave_sum(float v) {
#pragma unroll
    for (int o = 1; o < 64; o <<= 1) v += __shfl_xor(v, o);
    return v;
}
DI f32x4 mfma16(bf16x8 a, bf16x8 b, f32x4 c) { return __builtin_amdgcn_mfma_f32_16x16x32_bf16(a, b, c, 0, 0, 0); }
DI bf16x8 lds16(lptr p) { return *(const LAS bf16x8*)p; }
DI s16x4 ldstr(lptr p) { return __builtin_bit_cast(s16x4, __builtin_amdgcn_ds_read_tr16_b64_v4i16((LAS s16x4*)p)); }
DI bf16x8 cat4(s16x4 a, s16x4 b) { return (bf16x8){a[0], a[1], a[2], a[3], b[0], b[1], b[2], b[3]}; }
#define SCHED_FENCE() __builtin_amdgcn_sched_barrier(0)
DI float clamp448(float v) { return fminf(fmaxf(v, -448.f), 448.f); }
DI unsigned pk4_fp8(float a, float b, float c, float d) {
    int w = 0; w = __builtin_amdgcn_cvt_pk_fp8_f32(clamp448(a), clamp448(b), w, false); w = __builtin_amdgcn_cvt_pk_fp8_f32(clamp448(c), clamp448(d), w, true); return (unsigned)w; }
DI float silu_f(float x) { return x * __builtin_amdgcn_rcpf(1.f + __expf(-x)); }
DI float sigm_f(float x) { return __builtin_amdgcn_rcpf(1.f + __expf(-x)); }

namespace pg8 {
constexpr int BM = 256, BK = 64, HALF = 128, HTB = HALF * BK * 2, STAGE_BYTES = 8 * HTB, NXCD = 8, WGM = 8;
__host__ __device__ __forceinline__ int lds_byte(int r, int c) { const int st = (r >> 4) * 2 + (c >> 5), rr = r & 15, cc = c & 31, ob = rr * 64 + cc * 2; return st * 1024 + (ob ^ (((ob >> 9) & 1) << 5)); }
__host__ __device__ __forceinline__ void stage_rc(int b, int& R, int& C) { const int st = b / 1024, sb = b % 1024, swz = sb ^ (((sb >> 9) & 1) << 5); R = (st >> 1) * 16 + swz / 64; C = (st & 1) * 32 + (swz % 64) / 2; }
__host__ __device__ __forceinline__ int perm32(int rho) { const int n = rho >> 4, i = rho & 15; return 8 * (i >> 2) + 4 * n + (i & 3); }

struct Unit { const char* A; const char* B; int pm, pn, tag, aux; };

struct DenseOrder {
    int nM, nN, nwg, G, c;
    DI void init(int M, int N, int G_, int c_) { nM = M / BM; nN = N / BM; nwg = nM * nN; G = G_; c = c_; }
    DI bool tile(int i, int& pm, int& pn) const {
        const long L = (long)i * G + c; if (L >= nwg) return false;
        int wgid = (int)L; { const int q = nwg / NXCD, r = nwg % NXCD, xcd = wgid % NXCD, off = wgid / NXCD; wgid = (xcd < r ? xcd * (q + 1) : r * (q + 1) + (xcd - r) * q) + off; }
        const int nig = WGM * nN, gid = wgid / nig, fm = gid * WGM, gsz = (nM - fm) < WGM ? (nM - fm) : WGM;
        pm = fm + ((wgid % nig) % gsz); pn = (wgid % nig) / gsz; return true;
    }
};

typedef int v8i32 __attribute__((ext_vector_type(8)));
template <class Epi, class Sched, bool GATHER, bool FP8 = false>
DI void gemm_phase(lptr lds, const int pitch  , const Sched& S, const Epi& E, const int wid, const int scale_w = 127, const int scale_x = 127) {
    const int K = pitch >> 1;
    const int lane = lane_id(), tid = wid * 64 + lane, wr = wid >> 2, wc = wid & 3, fr = lane & 15, fq = lane >> 4;
    const int nt = pitch / (BK * 2);
    unsigned vA[2][2], nvA[2][2], voffB[2];
#pragma unroll
    for (int i = 0; i < 2; ++i) { int R, C; stage_rc(tid * 16 + i * 8192, R, C); const int Rb = (R & ~31) + perm32(R & 31);
        vA[0][i] = (unsigned)(R * K + C) * 2u; vA[1][i] = (unsigned)((R + HALF) * K + C) * 2u; voffB[i] = (unsigned)(Rb * K + C) * 2u;
        nvA[0][i] = vA[0][i]; nvA[1][i] = vA[1][i]; }
    const size_t kstep = (size_t)(BK * 2);
    const size_t hstep = (size_t)HALF * K * 2;
    const unsigned ldsw = (unsigned)wid * 1024u;
    const int aoff = FP8 ? lds_byte(wr * 64 + fr, fq * 16) : lds_byte(wr * 64 + fr, fq * 8), boff = FP8 ? lds_byte(wc * 32 + fr, fq * 16) : lds_byte(wc * 32 + fr, fq * 8);
#define PG8_SA(b, h) (((b) * 2 + (h)) * HTB)
#define PG8_SB(b, h) ((4 + (b) * 2 + (h)) * HTB)
#define PG8_STAGE(bufoff, gbase, voff) do { _Pragma("unroll") for (int _i = 0; _i < 2; ++_i) \
        __builtin_amdgcn_global_load_lds((const unsigned*)((const char*)(gbase) + (voff)[_i]), (LAS unsigned*)(lds + (bufoff) + ldsw + _i * 8192), 16, 0, 0); } while (0)
#define PG8_LD8(p_) __builtin_shufflevector(*(const LAS u32x4*)(p_), *(const LAS u32x4*)((p_) + 16), 0, 1, 2, 3, 4, 5, 6, 7)
#define PG8_LDA(dst, b, h) do { if constexpr (FP8) { _Pragma("unroll") for (int m = 0; m < 4; ++m) dst##8[m] = PG8_LD8(lds + PG8_SA(b, h) + aoff + m * 2048); } \
        else { _Pragma("unroll") for (int m = 0; m < 4; ++m) _Pragma("unroll") for (int k = 0; k < 2; ++k) dst[m][k] = *(const LAS bf16x8*)(lds + PG8_SA(b, h) + aoff + m * 2048 + k * 1024); } } while (0)
#define PG8_LDB(dst, b, h) do { if constexpr (FP8) { _Pragma("unroll") for (int n = 0; n < 2; ++n) dst##8[n] = PG8_LD8(lds + PG8_SB(b, h) + boff + n * 2048); } \
        else { _Pragma("unroll") for (int n = 0; n < 2; ++n) _Pragma("unroll") for (int k = 0; k < 2; ++k) dst[n][k] = *(const LAS bf16x8*)(lds + PG8_SB(b, h) + boff + n * 2048 + k * 1024); } } while (0)
#define PG8_MMA(ai, bj, At, Bt) do { __builtin_amdgcn_s_setprio(1); _Pragma("unroll") for (int m = 0; m < 4; ++m) _Pragma("unroll") for (int n = 0; n < 2; ++n) { \
        if constexpr (FP8) asm volatile("v_mfma_scale_f32_16x16x128_f8f6f4 %0, %1, %2, %0, %3, %4 op_sel_hi:[0,0,0]" : "+v"(acc[ai][bj][m][n]) : "v"(Bt##8[n]), "v"(At##8[m]), "v"(scw_), "v"(sca_));   \
        else { _Pragma("unroll") for (int k = 0; k < 2; ++k) acc[ai][bj][m][n] = __builtin_amdgcn_mfma_f32_16x16x32_bf16(Bt[n][k], At[m][k], acc[ai][bj][m][n], 0, 0, 0); } } \
        __builtin_amdgcn_s_setprio(0); } while (0)
#define PG8_WAIT_V(n) asm volatile("s_waitcnt vmcnt(" #n ")" ::: "memory")
#define PG8_WAIT_L(n) asm volatile("s_waitcnt lgkmcnt(" #n ")" ::: "memory")
#define PG8_BAR __builtin_amdgcn_s_barrier()
#define PG8_SCHED __builtin_amdgcn_sched_barrier(0)
    Unit cur, nxt; int ui = 0;
    if (!S.next(0, cur)) return;
    if constexpr (GATHER) {
        int t2 = tid; asm volatile("" : "+v"(t2));
#pragma unroll
        for (int i = 0; i < 2; ++i) { int R, C; stage_rc(t2 * 16 + i * 8192, R, C);
#pragma unroll
            for (int h = 0; h < 2; ++h) vA[h][i] = S.arow(cur, h * HALF + R) * (unsigned)(K * 2) + (unsigned)C * 2u; }
    }
    f32x4 acc[2][2][4][2];
#pragma unroll
    for (int a = 0; a < 2; ++a)
#pragma unroll
        for (int b = 0; b < 2; ++b)
#pragma unroll
            for (int m = 0; m < 4; ++m)
#pragma unroll
                for (int n = 0; n < 2; ++n) acc[a][b][m][n] = (f32x4){0.f, 0.f, 0.f, 0.f};
    bf16x8 At[4][2], B0[2][2], B1[2][2];
    typedef unsigned u32x8 __attribute__((ext_vector_type(8)));
    u32x8 At8[4], B08[2], B18[2];
    const int scw_ = scale_w, sca_ = scale_x;
    const char* cA = cur.A; const char* cB = cur.B;
    PG8_STAGE(PG8_SB(0, 0), cB, voffB); PG8_STAGE(PG8_SB(0, 1), cB + hstep, voffB); PG8_STAGE(PG8_SA(0, 0), cA, vA[0]); PG8_STAGE(PG8_SA(0, 1), cA, vA[1]);
    if (wr == 1) PG8_BAR;
    PG8_WAIT_V(2); PG8_BAR;
    PG8_STAGE(PG8_SB(1, 0), cB + kstep, voffB); PG8_STAGE(PG8_SA(1, 0), cA + kstep, vA[0]); PG8_STAGE(PG8_SB(1, 1), cB + hstep + kstep, voffB);
    PG8_WAIT_V(6); PG8_BAR;
    unsigned pre[Epi::NPRE > 0 ? Epi::NPRE : 1];
    for (;;) {
        const bool has_next = S.next(ui + 1, nxt);
        if constexpr (Epi::NPRE > 0) E.prefetch(pre, cur, wr, fr);
        const char* nA = has_next ? nxt.A : cA; const char* nB = has_next ? nxt.B : cB;
        unsigned nrid[2][2]; int nleft = 0;
        if constexpr (GATHER) {
            int t2 = tid; asm volatile("" : "+v"(t2));
            if (has_next) { nleft = S.rows_left(nxt);
#pragma unroll
                for (int i = 0; i < 2; ++i) { int R, C; stage_rc(t2 * 16 + i * 8192, R, C);
#pragma unroll
                    for (int h = 0; h < 2; ++h) asm volatile("global_load_dword %0, %1, off" : "=v"(nrid[h][i]) : "v"(S.arow_ptr(nxt, h * HALF + R)) : "memory"); }
            } else {
#pragma unroll
                for (int i = 0; i < 2; ++i)
#pragma unroll
                    for (int h = 0; h < 2; ++h) { nvA[h][i] = vA[h][i]; nrid[h][i] = 0u; }
            }
        }
#pragma unroll 1
        for (int t = 0; t < nt; t += 2) {
            const bool last = (t == nt - 2);
            const char* a1 = cA + (size_t)(t + 1) * kstep;
            const char* a2 = last ? nA : cA + (size_t)(t + 2) * kstep; const char* b2 = last ? nB : cB + (size_t)(t + 2) * kstep;
            const char* a3 = a2 + kstep; const char* b3 = b2 + kstep;
            unsigned wA[2][2];
            if constexpr (GATHER) {
                if (last && has_next) {
                    int t2 = tid; asm volatile("" : "+v"(t2));
#pragma unroll
                    for (int i = 0; i < 2; ++i) { int R, C; stage_rc(t2 * 16 + i * 8192, R, C);
#pragma unroll
                        for (int h = 0; h < 2; ++h) { unsigned r_ = nrid[h][i]; asm volatile("" : "+v"(r_));
                            nvA[h][i] = ((h * HALF + R) < nleft ? (r_ >> 1) : 0u) * (unsigned)(K * 2) + (unsigned)C * 2u; } }
                }
            }
#pragma unroll
            for (int h = 0; h < 2; ++h)
#pragma unroll
                for (int i = 0; i < 2; ++i) wA[h][i] = GATHER ? (last ? nvA[h][i] : vA[h][i]) : vA[h][i];
            PG8_LDB(B0, 0, 0); PG8_LDB(B1, 0, 1); PG8_SCHED; PG8_LDA(At, 0, 0); PG8_STAGE(PG8_SA(1, 1), a1, vA[1]);
            PG8_WAIT_V(8); PG8_WAIT_L(0); PG8_BAR; PG8_MMA(0, 0, At, B0); PG8_MMA(0, 1, At, B1); PG8_BAR; PG8_SCHED;
            PG8_LDA(At, 0, 1); PG8_STAGE(PG8_SB(0, 0), b2, voffB); PG8_STAGE(PG8_SB(0, 1), b2 + hstep, voffB); PG8_STAGE(PG8_SA(0, 0), a2, wA[0]);
            PG8_WAIT_V(8); PG8_WAIT_L(0); PG8_BAR; PG8_MMA(1, 0, At, B0); PG8_MMA(1, 1, At, B1); PG8_BAR; PG8_SCHED;
            PG8_LDB(B0, 1, 0); PG8_LDB(B1, 1, 1); PG8_SCHED; PG8_LDA(At, 1, 0); PG8_STAGE(PG8_SA(0, 1), a2, wA[1]);
            PG8_WAIT_V(8); PG8_WAIT_L(0); PG8_BAR; PG8_MMA(0, 0, At, B0); PG8_MMA(0, 1, At, B1); PG8_BAR; PG8_SCHED;
            PG8_LDA(At, 1, 1); PG8_STAGE(PG8_SB(1, 0), b3, voffB); PG8_STAGE(PG8_SB(1, 1), b3 + hstep, voffB); PG8_STAGE(PG8_SA(1, 0), a3, wA[0]);
            PG8_WAIT_V(8); PG8_WAIT_L(0); PG8_BAR; PG8_MMA(1, 0, At, B0); PG8_MMA(1, 1, At, B1); PG8_BAR; PG8_SCHED;
        }
        if (wr == 0) PG8_BAR;
        if constexpr (FP8) asm volatile("s_nop 15\n\ts_nop 7" ::: "memory");
        if constexpr (Epi::NPRE > 0) E(acc, cur, wr, wc, fr, fq, pre); else E(acc, cur, wr, wc, fr, fq);
        if (!has_next) break;
#pragma unroll
        for (int a = 0; a < 2; ++a)
#pragma unroll
            for (int b = 0; b < 2; ++b)
#pragma unroll
                for (int m = 0; m < 4; ++m)
#pragma unroll
                    for (int n = 0; n < 2; ++n) acc[a][b][m][n] = (f32x4){0.f, 0.f, 0.f, 0.f};
        cur = nxt; cA = nA; cB = nB; ++ui;
        if constexpr (GATHER) {
#pragma unroll
            for (int h = 0; h < 2; ++h)
#pragma unroll
                for (int i = 0; i < 2; ++i) vA[h][i] = nvA[h][i];
        }
        if (wr == 1) PG8_BAR;
    }
    PG8_WAIT_V(0);
    PG8_BAR;
#undef PG8_SA
#undef PG8_SB
#undef PG8_STAGE
#undef PG8_LDA
#undef PG8_LDB
#undef PG8_MMA
#undef PG8_LD8
#undef PG8_WAIT_V
#undef PG8_WAIT_L
#undef PG8_BAR
#undef PG8_SCHED
}
}


#define XB_TMO      128
#define XB_XCNT(j)  (256  + 64 * (j))
#define XB_XSUB(j)  (1280 + 64 * (j))
#define XB_XGEN(j)  (2304 + 64 * (j))
#define XB_TOP      3328
#define XB_TOPGEN   3392
#define XCD_BAR_WORDS 3456
#define XB_SPIN_CAP (1u << 20)
DI unsigned xb_ld(unsigned* p)              { return __hip_atomic_load(p, __ATOMIC_RELAXED, __HIP_MEMORY_SCOPE_AGENT); }
DI unsigned xb_add(unsigned* p, unsigned v) { return __hip_atomic_fetch_add(p, v, __ATOMIC_RELAXED, __HIP_MEMORY_SCOPE_AGENT); }
DI unsigned xb_xcc_id() { return (unsigned)__builtin_amdgcn_s_getreg((3 << 11) | 20) & 0xFu; }
#define XB_SPIN(cond, bar) do { unsigned _sp = 0; while (cond) { __builtin_amdgcn_s_sleep(1); \
    if ((++_sp & 255u) == 0u) { if (xb_ld(&(bar)[XB_TMO])) break; if (_sp > XB_SPIN_CAP) { atomicAdd(&(bar)[XB_TMO], 1u); break; } } } } while (0)
struct XcdBarrier { unsigned* bar; unsigned x; volatile LAS unsigned* st; };
DI XcdBarrier xcd_barrier_post(unsigned* bar, volatile LAS unsigned* st, bool leader) {
    XcdBarrier b; b.bar = bar; b.x = xb_xcc_id(); b.st = st;
    if (leader) (void)xb_add(&bar[XB_XCNT(b.x)], 1u);
    return b;
}
DI void xcd_barrier_complete(unsigned* bar, unsigned x, unsigned& nloc, unsigned& nx) {
    const unsigned G = gridDim.x;
    unsigned sum, cnt, mine, sp = 0u;
    for (;;) {
        sum = 0u; cnt = 0u; mine = 0u;
#pragma unroll
        for (unsigned j = 0; j < 16; ++j) { const unsigned c = xb_ld(&bar[XB_XCNT(j)]); sum += c; cnt += (c > 0u) ? 1u : 0u; mine = (j == x) ? c : mine; }
        if (sum == G) break;
        __builtin_amdgcn_s_sleep(1);
        if ((++sp & 255u) == 0u) { if (xb_ld(&bar[XB_TMO])) break; if (sp > XB_SPIN_CAP) { atomicAdd(&bar[XB_TMO], 1u); break; } }
    }
    nloc = mine > 0u ? mine : 1u; nx = cnt > 0u ? cnt : 1u;
}
DI void xcd_barrier(const XcdBarrier& b, bool leader) {
    asm volatile("s_waitcnt vmcnt(0)" ::: "memory");
    __syncthreads();
    if (leader) {
        unsigned* bar = b.bar;
        __builtin_amdgcn_s_waitcnt(0);
        unsigned nloc = b.st[0], nx = b.st[1];
        if (nloc == 0u) { xcd_barrier_complete(bar, b.x, nloc, nx); b.st[0] = nloc; b.st[1] = nx; }
        const unsigned old = xb_add(&bar[XB_XSUB(b.x)], 1u);
        const unsigned gen = old / nloc;
        if (old + 1u == (gen + 1u) * nloc) {
            __builtin_amdgcn_fence(__ATOMIC_RELEASE, "agent");
            asm volatile("s_waitcnt vmcnt(0)" ::: "memory");
            const unsigned og = xb_add(&bar[XB_TOP], 1u);
            const unsigned tg = og / nx;
            if (og + 1u == (tg + 1u) * nx) xb_add(&bar[XB_TOPGEN], 1u);
            else XB_SPIN(xb_ld(&bar[XB_TOPGEN]) == tg, bar);
            __builtin_amdgcn_fence(__ATOMIC_ACQUIRE, "agent");
            xb_add(&bar[XB_XGEN(b.x)], 1u);
            asm volatile("s_waitcnt vmcnt(0)" ::: "memory");
        } else {
            XB_SPIN(xb_ld(&bar[XB_XGEN(b.x)]) == gen, bar);
            __builtin_amdgcn_fence(__ATOMIC_ACQUIRE, "agent");
            asm volatile("s_waitcnt vmcnt(0)" ::: "memory");
        }
    }
    __syncthreads();
}

struct Args { const float* in[24]; float* out; unsigned char* ws; int ph_lo, ph_hi, dupk, dbg; };
struct Frame {
    lptr lds; int wave, vcu, G, bx;
    unsigned char* ws;
};

template <class RMap, bool FP8OUT = false>
DI void p0_transpose_item(const float* W, int ldn, int K, bf16_t* WT, LAS float* scr, int k0, int n0, int lane, const float* kscale, const RMap& rmap) {
    f32x4 v[8]; float ksc[8];
    const int r8 = lane >> 3, c4 = (lane & 7) * 4;
#pragma unroll
    for (int i = 0; i < 8; ++i) { v[i] = *(const f32x4*)(W + (size_t)(k0 + r8 + 8 * i) * ldn + n0 + c4); ksc[i] = kscale ? kscale[k0 + r8 + 8 * i] : 1.f; }
#pragma unroll
    for (int i = 0; i < 8; ++i) { LAS float* d = scr + (r8 + 8 * i) * 33 + c4; d[0] = v[i][0] * ksc[i]; d[1] = v[i][1] * ksc[i]; d[2] = v[i][2] * ksc[i]; d[3] = v[i][3] * ksc[i]; }
    asm volatile("s_waitcnt lgkmcnt(0)" ::: "memory");
    const int c = lane & 7;
#pragma unroll
    for (int j = 0; j < 4; ++j) { const int n = (lane >> 3) + 8 * j; const LAS float* s = scr + (8 * c) * 33 + n; float cs; const long orow = rmap(n0 + n, cs);
        if constexpr (FP8OUT) { u32x2 o; o.x = pk4_fp8(s[0 * 33] * cs, s[1 * 33] * cs, s[2 * 33] * cs, s[3 * 33] * cs); o.y = pk4_fp8(s[4 * 33] * cs, s[5 * 33] * cs, s[6 * 33] * cs, s[7 * 33] * cs);
            *(u32x2*)((unsigned char*)WT + (size_t)orow * K + k0 + 8 * c) = o; }
        else {
        u32x4 o; o.x = pk2(s[0 * 33] * cs, s[1 * 33] * cs); o.y = pk2(s[2 * 33] * cs, s[3 * 33] * cs); o.z = pk2(s[4 * 33] * cs, s[5 * 33] * cs); o.w = pk2(s[6 * 33] * cs, s[7 * 33] * cs);
        *(u32x4*)(WT + (size_t)orow * K + k0 + 8 * c) = o; } }
    asm volatile("s_waitcnt lgkmcnt(0)" ::: "memory");
}
struct RMapId { DI long operator()(int n, float& cs) const { cs = 1.f; return n; } };
struct RMapScale { float s; DI long operator()(int n, float& cs) const { cs = s; return n; } };
struct RMapKV { DI long operator()(int n, float& cs) const { cs = n < DM ? 0.015625f : 1.f; return n; } };
struct RMapWin {
    DI long operator()(int n, float& cs) const {
        cs = (n >= 256 && n < 512) ? 0.125f : 1.f;
        if (n < 512) { const int d = n & 63, p = (d < 32) ? 2 * d : 2 * (d - 32) + 1; return (n & ~63) + p; }
        return n;
    }
};
struct RMapGU { int up; DI long operator()(int n, float& cs) const { cs = 1.f; return (long)(n >> 7) * 256 + up * 128 + (n & 127); } };

DI void p0_prologue(Frame& F, const Args& a) {
    unsigned char* ws = F.ws;
    LAS float* scr = (LAS float*)(F.lds + F.wave * 16384);
    const int gw = F.vcu * NWAVES + F.wave, NGW = F.G * NWAVES, lane = lane_id(), tid0 = F.wave * 64 + lane;
    const float* g_mix = a.in[2]; const float* g_xa = a.in[10]; const float* g_mem = a.in[11]; const float* g_moe = a.in[15];
    constexpr int I_WIN = 16 * 112, I_SQ = 16 * 32, I_WKV = 16 * 64, I_GU = 32 * 16 * 16, I_DN = 32 * 8 * 32;
    constexpr int NITEMS = I_WIN + 3 * I_SQ + I_WKV;
    for (int it = gw; it < NITEMS; it += NGW) {
        int r = it;
        if (r < I_WIN) { p0_transpose_item(a.in[3], INW, DM, (bf16_t*)(ws + WS_WIN), scr, 64 * (r / 112), 32 * (r % 112), lane, g_mix, RMapWin{}); continue; } r -= I_WIN;
        if (r < I_SQ) { p0_transpose_item(a.in[9], DM, DM, (bf16_t*)(ws + WS_WOUT), scr, 64 * (r / 32), 32 * (r % 32), lane, nullptr, RMapId{}); continue; } r -= I_SQ;
        if (r < I_SQ) { p0_transpose_item<RMapScale, true>(a.in[12], DM, DM, (bf16_t*)(ws + WS_WQ), scr, 64 * (r / 32), 32 * (r % 32), lane, g_xa, RMapScale{0.0625f * 1.4426950408889634f * 512.f}); continue; }   r -= I_SQ;
        if (r < I_SQ) { p0_transpose_item<RMapScale, true>(a.in[14], DM, DM, (bf16_t*)(ws + WS_WO), scr, 64 * (r / 32), 32 * (r % 32), lane, nullptr, RMapScale{32.f}); continue; }   r -= I_SQ;
        { p0_transpose_item<RMapScale, true>(a.in[13], 2 * DM, DM, (bf16_t*)(ws + WS_WKV), scr, 64 * (r / 64), 32 * (r % 64), lane, g_mem, RMapScale{32.f}); }
    }
    {
        bf16_t* hi = (bf16_t*)(ws + WS_WR); bf16_t* lo = hi + 48 * 1024;
        const float* wg = a.in[16]; const float* wr_ = a.in[18];
        for (int idx = (F.vcu * NTHR + tid0); idx < 48 * 1024; idx += F.G * NTHR) {
            const int row = idx >> 10, k = idx & 1023; float v = 0.f;
            if (row < 32) { const int g = (row & 15) >> 2, i = (row & 3) + 4 * (row >> 4); v = wr_[(size_t)k * 32 + 8 * g + i] * g_moe[k]; }
            else if ((row & 3) == 0) { v = wg[(size_t)k * 4 + ((row - 32) >> 2)] * g_moe[k]; }
            const unsigned h = pk2(v, 0.f) & 0xffffu; const float r = v - bf2f((unsigned short)h);
            hi[idx] = (bf16_t)h; lo[idx] = (bf16_t)(pk2(r, 0.f) & 0xffffu);
        }
    }
    {
        f32x2* tab = (f32x2*)(ws + WS_ROPE);
        for (int idx = (F.vcu * NTHR + tid0); idx < SEQ * 32; idx += F.G * NTHR) {
            const int pos = idx >> 5, i = idx & 31; const float inv = powf(10000.0f, -(float)i / 32.0f); const float ang = (float)pos * inv;
            tab[idx] = (f32x2){cosf(ang), sinf(ang)};
        }
    }
    {
        float wgt[4][4][8];
#pragma unroll
        for (int jj = 0; jj < 4; ++jj)
#pragma unroll
            for (int c = 0; c < 4; ++c) { const int k = 256 * jj + 4 * lane + c; const float g = g_mix[k];
                const f32x4 w0 = *(const f32x4*)(a.in[3] + (size_t)k * INW + NP1), w1 = *(const f32x4*)(a.in[3] + (size_t)k * INW + NP1 + 4);
#pragma unroll
                for (int j = 0; j < 4; ++j) { wgt[jj][c][j] = w0[j] * g; wgt[jj][c][4 + j] = w1[j] * g; } }
        const float gb = a.in[7][lane & 7];
        bf16_t* xn0 = (bf16_t*)(ws + WS_XN0); float* gates = (float*)(ws + WS_GATES);
        f32x4 v[4];
        if (gw < NT) { const f32x4* xr = (const f32x4*)(a.in[0] + (size_t)gw * DM) + lane;
#pragma unroll
            for (int j = 0; j < 4; ++j) v[j] = xr[64 * j]; }
        for (int m = gw; m < NT; m += NGW) {
            f32x4 vn[4]; const int mn = (m + NGW < NT) ? m + NGW : m;
            { const f32x4* xr = (const f32x4*)(a.in[0] + (size_t)mn * DM) + lane;
#pragma unroll
                for (int j = 0; j < 4; ++j) vn[j] = xr[64 * j]; }
            float s = 0.f;
#pragma unroll
            for (int j = 0; j < 4; ++j) s += (v[j].x * v[j].x + v[j].y * v[j].y) + (v[j].z * v[j].z + v[j].w * v[j].w);
            const float rstd = rsqrtf(wave_sum(s) * (1.f / DM) + EPS);
            float gacc[8];
#pragma unroll
            for (int j = 0; j < 8; ++j) gacc[j] = 0.f;
#pragma unroll
            for (int jj = 0; jj < 4; ++jj)
#pragma unroll
                for (int c = 0; c < 4; ++c)
#pragma unroll
                    for (int j = 0; j < 8; ++j) gacc[j] += v[jj][c] * wgt[jj][c][j];
            unsigned long long* o8 = (unsigned long long*)(xn0 + (size_t)m * DM) + lane;
#pragma unroll
            for (int j = 0; j < 4; ++j) o8[64 * j] = (unsigned long long)pk2(v[j].x * rstd, v[j].y * rstd) | ((unsigned long long)pk2(v[j].z * rstd, v[j].w * rstd) << 32);
            float r4[4], r2[2], r1;
#pragma unroll
            for (int j = 0; j < 4; ++j) { const float mine = (lane & 1) ? gacc[2 * j + 1] : gacc[2 * j], oth = (lane & 1) ? gacc[2 * j] : gacc[2 * j + 1]; r4[j] = mine + __shfl_xor(oth, 1); }
#pragma unroll
            for (int j = 0; j < 2; ++j) { const float mine = (lane & 2) ? r4[2 * j + 1] : r4[2 * j], oth = (lane & 2) ? r4[2 * j] : r4[2 * j + 1]; r2[j] = mine + __shfl_xor(oth, 2); }
            { const float mine = (lane & 4) ? r2[1] : r2[0], oth = (lane & 4) ? r2[0] : r2[1]; r1 = mine + __shfl_xor(oth, 4); }
            r1 += __shfl_xor(r1, 8); r1 += __shfl_xor(r1, 16); r1 += __shfl_xor(r1, 32);
            if (lane < 8) gates[(size_t)m * 8 + lane] = r1 * rstd + gb;
            if (lane == 8) ((float*)(ws + WS_RMS))[m] = __builtin_amdgcn_rcpf(rstd);
#pragma unroll
            for (int j = 0; j < 4; ++j) v[j] = vn[j];
        }
    }
    {
        unsigned char* memn = ws + WS_MEMN;
        for (int m = gw; m < MEMT; m += NGW) {
            const f32x4* xr = (const f32x4*)(a.in[1] + (size_t)m * DM) + lane;
            f32x4 v[4]; float s = 0.f;
#pragma unroll
            for (int j = 0; j < 4; ++j) { v[j] = xr[64 * j]; s += (v[j].x * v[j].x + v[j].y * v[j].y) + (v[j].z * v[j].z + v[j].w * v[j].w); }
            const float rstd = rsqrtf(wave_sum(s) * (1.f / DM) + EPS);
            unsigned* o4 = (unsigned*)(memn + (size_t)m * DM) + lane;
#pragma unroll
            for (int j = 0; j < 4; ++j) o4[64 * j] = pk4_fp8(v[j].x * rstd, v[j].y * rstd, v[j].z * rstd, v[j].w * rstd);
        }
    }
}


struct SchedDense {
    pg8::DenseOrder o; const char* A; const char* B; int K;
    DI bool next(int i, pg8::Unit& u) const { int pm, pn; if (!o.tile(i, pm, pn)) return false; u.A = A + (size_t)pm * 256 * K * 2; u.B = B + (size_t)pn * 256 * K * 2; u.pm = pm; u.pn = pn; u.tag = 0; u.aux = 0; return true; }
    DI unsigned arow(const pg8::Unit&, int) const { return 0u; }
};
struct SchedP1 {
    pg8::DenseOrder o1, o2; const char *A1, *B1, *A2, *B2; int n1;
    DI bool next(int i, pg8::Unit& u) const {
        int pm, pn;
        if (i < n1) { o1.tile(i, pm, pn); u.A = A1 + (size_t)pm * 256 * DM * 2; u.B = B1 + (size_t)pn * 256 * DM * 2; u.pm = pm; u.pn = pn; u.tag = 0; u.aux = 0; return true; }
        if (!o2.tile(i - n1, pm, pn)) return false;
        u.A = A2 + (size_t)pm * 256 * DM * 2; u.B = B2 + (size_t)pn * 256 * DM * 2; u.pm = pm; u.pn = pn; u.tag = 1; u.aux = 0; return true;
    }
    DI unsigned arow(const pg8::Unit&, int) const { return 0u; }
};

struct SchedKV {
    int first, step; const char *A, *B;
    DI bool next(int i, pg8::Unit& u) const { const int li = first + i * step; if (li >= 256) return false; u.pm = li >> 3; u.pn = li & 7; u.A = A + (size_t)u.pm * 256 * DM; u.B = B + (size_t)u.pn * 256 * DM;
        if (u.pn >= 4) { const char* t = u.A; u.A = u.B; u.B = t; }
        u.tag = 1; u.aux = 0; return true; }
    DI unsigned arow(const pg8::Unit&, int) const { return 0u; }
};
struct EpiP1 {
    static constexpr int NPRE = 0;
    bf16_t* proj; bf16_t* kvb; const f32x4* rope;
    DI void operator()(const f32x4 (&acc)[2][2][4][2], const pg8::Unit& u, int wr, int wc, int fr, int fq) const {
        asm volatile("" : "+v"(fr), "+v"(fq));
        const int row0 = u.pm * 256 + wr * 64 + fr, col0 = u.pn * 256 + wc * 32 + 8 * fq;
        const int mode = (u.tag == 1) ? 0 : (u.pn < 2 ? 1 : ((u.pn == 4 || u.pn == 5) ? 2 : ((u.pn == 12 || u.pn == 13) ? 3 : 0)));
        bf16_t* base = (u.tag == 1) ? kvb + ((size_t)(((u.pn >> 2) * NB + u.pm) * 4 + (u.pn & 3)) << 16) - (size_t)u.pm * 256 * 256 - (size_t)u.pn * 256 : proj; const int ldc = (u.tag == 1) ? 256 : NP1;
        f32x4 rt[2][4][2];
        if (mode == 1) {
#pragma unroll
            for (int ai = 0; ai < 2; ++ai)
#pragma unroll
                for (int m = 0; m < 4; ++m) { const f32x4* tp = rope + (size_t)((row0 + ai * 128 + m * 16) & (SEQ - 1)) * 16 + ((wc & 1) * 16 + 4 * fq) / 2; rt[ai][m][0] = tp[0]; rt[ai][m][1] = tp[1]; }
        }
        SCHED_FENCE();
#pragma unroll
        for (int ai = 0; ai < 2; ++ai)
#pragma unroll
            for (int m = 0; m < 4; ++m) {
                const int grow = row0 + ai * 128 + m * 16; bf16_t* rowp = base + (size_t)grow * ldc + col0;
                f32x4 t0 = {1.f, 0.f, 1.f, 0.f}, t1 = {1.f, 0.f, 1.f, 0.f};
                if (mode == 1) { t0 = rt[ai][m][0]; t1 = rt[ai][m][1]; }
#pragma unroll
                for (int bj = 0; bj < 2; ++bj) {
                    f32x4 v0 = acc[ai][bj][m][0], v1 = acc[ai][bj][m][1];
                    if (mode == 1) {
                        f32x4 r0, r1;
                        r0[0] = v0[0] * t0[0] - v0[1] * t0[1]; r0[1] = v0[0] * t0[1] + v0[1] * t0[0];
                        r0[2] = v0[2] * t0[2] - v0[3] * t0[3]; r0[3] = v0[2] * t0[3] + v0[3] * t0[2];
                        r1[0] = v1[0] * t1[0] - v1[1] * t1[1]; r1[1] = v1[0] * t1[1] + v1[1] * t1[0];
                        r1[2] = v1[2] * t1[2] - v1[3] * t1[3]; r1[3] = v1[2] * t1[3] + v1[3] * t1[2];
                        v0 = r0; v1 = r1;
                    } else if (mode == 2) {
#pragma unroll
                        for (int j = 0; j < 4; ++j) { v0[j] = silu_f(v0[j]); v1[j] = silu_f(v1[j]); }
                    } else if (mode == 3) {
#pragma unroll
                        for (int j = 0; j < 4; ++j) { v0[j] = sigm_f(v0[j]); v1[j] = sigm_f(v1[j]); }
                    }
                    u32x4 w; w.x = pk2(v0[0], v0[1]); w.y = pk2(v0[2], v0[3]); w.z = pk2(v1[0], v1[1]); w.w = pk2(v1[2], v1[3]);
                    *(u32x4*)(rowp + bj * 128) = w;
                }
            }
    }
};
struct EpiKV8 {
    static constexpr int NPRE = 0;
    unsigned char* kv8;
    DI void operator()(const f32x4 (&acc)[2][2][4][2], const pg8::Unit& u, int wr, int wc, int fr, int fq) const {
        asm volatile("" : "+v"(fr), "+v"(fq));
        unsigned char* blk = kv8 + ((size_t)(((u.pn >> 2) * NB + u.pm) * 4 + (u.pn & 3)) << 16);
#pragma unroll
        for (int ai = 0; ai < 2; ++ai)
#pragma unroll
            for (int m = 0; m < 4; ++m)
#pragma unroll
                for (int bj = 0; bj < 2; ++bj) { const f32x4 v0 = acc[ai][bj][m][0], v1 = acc[ai][bj][m][1];
                    u32x2 w8; w8.x = pk4_fp8(v0[0], v0[1], v0[2], v0[3]); w8.y = pk4_fp8(v1[0], v1[1], v1[2], v1[3]);
                    *(u32x2*)(blk + (ai * 128 + wr * 64 + m * 16 + fr) * 256 + bj * 128 + wc * 32 + 8 * fq) = w8; }
    }
};
struct EpiP3 {
    static constexpr int NPRE = 0;
    const bf16_t* xn0; const float* rms; bf16_t* x1b; float* ssq; unsigned char* x1q8;
    DI void operator()(const f32x4 (&acc)[2][2][4][2], const pg8::Unit& u, int wr, int wc, int fr, int fq) const {
        asm volatile("" : "+v"(fr), "+v"(fq));
        const int row0 = u.pm * 256 + wr * 64 + fr, col0 = u.pn * 256 + wc * 32 + 8 * fq;
#pragma unroll
        for (int ai = 0; ai < 2; ++ai) {
            u32x4 xv[4][2]; float rm[4];
#pragma unroll
            for (int m = 0; m < 4; ++m) { rm[m] = rms[row0 + ai * 128 + m * 16];
#pragma unroll
                for (int bj = 0; bj < 2; ++bj) xv[m][bj] = *(const u32x4*)(xn0 + (size_t)(row0 + ai * 128 + m * 16) * DM + col0 + bj * 128); }
            SCHED_FENCE();
#pragma unroll
            for (int m = 0; m < 4; ++m) {
                const int grow = row0 + ai * 128 + m * 16; float s = 0.f;
#pragma unroll
                for (int bj = 0; bj < 2; ++bj) {
                    const u32x4 r = xv[m][bj]; const float rmm = rm[m];
                    const f32x4 v0 = acc[ai][bj][m][0] + (f32x4){bflo(r.x), bfhi(r.x), bflo(r.y), bfhi(r.y)} * rmm, v1 = acc[ai][bj][m][1] + (f32x4){bflo(r.z), bfhi(r.z), bflo(r.w), bfhi(r.w)} * rmm;
                    u32x4 w; w.x = pk2(v0[0], v0[1]); w.y = pk2(v0[2], v0[3]); w.z = pk2(v1[0], v1[1]); w.w = pk2(v1[2], v1[3]);
                    *(u32x4*)(x1b + (size_t)grow * DM + col0 + bj * 128) = w;
                    { u32x2 w8; w8.x = pk4_fp8(v0[0], v0[1], v0[2], v0[3]); w8.y = pk4_fp8(v1[0], v1[1], v1[2], v1[3]); *(u32x2*)(x1q8 + (size_t)grow * DM + col0 + bj * 128) = w8; }
                    const float a0 = bflo(w.x), a1 = bfhi(w.x), a2 = bflo(w.y), a3 = bfhi(w.y), a4 = bflo(w.z), a5 = bfhi(w.z), a6 = bflo(w.w), a7 = bfhi(w.w);
                    s += (a0 * a0 + a1 * a1) + (a2 * a2 + a3 * a3) + (a4 * a4 + a5 * a5) + (a6 * a6 + a7 * a7);
                }
                s += __shfl_xor(s, 16); s += __shfl_xor(s, 32);
                if (fq == 0) ssq[(size_t)grow * 16 + u.pn * 4 + wc] = s;
            }
            SCHED_FENCE();
        }
    }
};

constexpr int RQ_OFF = 0, RK_OFF = 18432, RV_OFF = 36864, RRT_OFF = 73728, RNW_OFF = 92160, RSTG_OFF = 94208;
DI void headnorm_store(f32x4 (&x)[8], const LAS float* nw, const u32x4 (&gq)[4], lptr stg, bf16_t* outw, int lane, int exor) {
    const int fr = lane & 15, fq = lane >> 4;
#pragma unroll
    for (int it = 0; it < 4; ++it) *(LAS u32x4*)(stg + (fq + 4 * it) * 272 + 16 * fr) = gq[it];
    float s = 0.f;
#pragma unroll
    for (int eb = 0; eb < 8; ++eb) s += (x[eb][0] + x[eb][1]) + (x[eb][2] + x[eb][3]);
    s += __shfl_xor(s, 16); s += __shfl_xor(s, 32);
    const float mu = s * (1.f / 128.f); float q = 0.f;
#pragma unroll
    for (int eb = 0; eb < 8; ++eb) { x[eb] = x[eb] - mu; q += (x[eb][0] * x[eb][0] + x[eb][1] * x[eb][1]) + (x[eb][2] * x[eb][2] + x[eb][3] * x[eb][3]); }
    q += __shfl_xor(q, 16); q += __shfl_xor(q, 32);
    const float rs = rsqrtf(q * (1.f / 128.f) + EPS);
#pragma unroll
    for (int eb = 0; eb < 8; ++eb) {
        const int e0 = 16 * (eb ^ exor) + 4 * fq;
        const f32x4 wv = *(const LAS f32x4*)(nw + e0); const u32x2 gv = *(const LAS u32x2*)(stg + fr * 272 + e0 * 2);
        u32x2 o; o.x = pk2(x[eb][0] * rs * wv[0] * bflo(gv.x), x[eb][1] * rs * wv[1] * bfhi(gv.x)); o.y = pk2(x[eb][2] * rs * wv[2] * bflo(gv.y), x[eb][3] * rs * wv[3] * bfhi(gv.y));
        *(LAS u32x2*)(stg + fr * 272 + e0 * 2) = o;
    }
#pragma unroll
    for (int it = 0; it < 4; ++it) { const u32x4 v = *(const LAS u32x4*)(stg + (fq + 4 * it) * 272 + 16 * fr); *(u32x4*)(outw + (size_t)(fq + 4 * it) * DM + 8 * fr) = v; }
}
DI void ret_item(Frame& F, const Args& a, int b, int h) {
    const lptr L = F.lds; const int w = F.wave;
    const bf16_t* proj = (const bf16_t*)(F.ws + WS_PROJ); bf16_t* mix = (bf16_t*)(F.ws + WS_MIX);
    const float lg2 = log1pf(-exp2f(-5.f - (float)h)) * 1.4426950408889634f;
    const float g128 = exp2f(128.f * lg2);
    const int db = w >> 1, ebase = 4 * (w & 1);
    LAS float* nw = (LAS float*)(L + RNW_OFF);
    { const int t_ = F.wave * 64 + lane_id(); if (t_ < 128) nw[t_] = a.in[4][h * 128 + t_]; }
    f32x4 Racc[4];
#pragma unroll
    for (int t = 0; t < 4; ++t) Racc[t] = (f32x4){0.f, 0.f, 0.f, 0.f};
    for (int i = F.wave * 64 + lane_id(); i < 18432 / 16; i += NTHR) *(LAS u32x4*)(L + RRT_OFF + i * 16) = (u32x4){0u, 0u, 0u, 0u};
    u32x4 pq[2], pk[2], pv[4];
    {
        const int tid = F.wave * 64 + lane_id(); const size_t row0 = (size_t)b * SEQ;
#pragma unroll
        for (int i = 0; i < 2; ++i) { const int p = tid + i * NTHR, r = p >> 3, ch = p & 7; const bf16_t* src = proj + (row0 + r) * NP1 + h * 64 + ch * 8; pq[i] = *(const u32x4*)src; pk[i] = *(const u32x4*)(src + 256); }
#pragma unroll
        for (int i = 0; i < 4; ++i) { const int p = tid + i * NTHR, r = p >> 4, ch = p & 15; pv[i] = *(const u32x4*)(proj + (row0 + r) * NP1 + 512 + h * 128 + ch * 8); }
    }
    for (int c = 0; c < 16; ++c) {
        const size_t row0 = (size_t)b * SEQ + c * 128;
        int tid = F.wave * 64 + lane_id(); asm volatile("" : "+v"(tid));
        const int lane = tid & 63, fr = lane & 15, fq = lane >> 4;
        __syncthreads();
        if (c > 0) {
#pragma unroll
            for (int t = 0; t < 4; ++t) { u32x2 pk_; pk_.x = pk2(Racc[t][0], Racc[t][1]); pk_.y = pk2(Racc[t][2], Racc[t][3]);
                *(LAS u32x2*)(L + RRT_OFF + (16 * (ebase + t) + fr) * 144 + (16 * db + 4 * fq) * 2) = pk_; }
        }
#pragma unroll
        for (int i = 0; i < 2; ++i) { const int p = tid + i * NTHR, r = p >> 3, ch = p & 7;
            *(LAS u32x4*)(L + RQ_OFF + r * 144 + ch * 16) = pq[i]; *(LAS u32x4*)(L + RK_OFF + r * 144 + ch * 16) = pk[i]; }
#pragma unroll
        for (int i = 0; i < 4; ++i) { const int p = tid + i * NTHR, r = p >> 4, ch = p & 15; u32x4 v = pv[i];
            const float sc = exp2f((float)(127 - r) * lg2);
            v.x = pk2(bflo(v.x) * sc, bfhi(v.x) * sc); v.y = pk2(bflo(v.y) * sc, bfhi(v.y) * sc); v.z = pk2(bflo(v.z) * sc, bfhi(v.z) * sc); v.w = pk2(bflo(v.w) * sc, bfhi(v.w) * sc);
            *(LAS u32x4*)(L + RV_OFF + r * 288 + ch * 16) = v; }
        __syncthreads();
        {
            const size_t rown = (size_t)b * SEQ + (c < 15 ? c + 1 : c) * 128;
#pragma unroll
            for (int i = 0; i < 2; ++i) { const int p = tid + i * NTHR, r = p >> 3, ch = p & 7; const bf16_t* src = proj + (rown + r) * NP1 + h * 64 + ch * 8; pq[i] = *(const u32x4*)src; pk[i] = *(const u32x4*)(src + 256); }
#pragma unroll
            for (int i = 0; i < 4; ++i) { const int p = tid + i * NTHR, r = p >> 4, ch = p & 15; pv[i] = *(const u32x4*)(proj + (rown + r) * NP1 + 512 + h * 128 + ch * 8); }
        }
        const size_t grow = row0 + 16 * w + fr;
        u32x4 gq[4];
#pragma unroll
        for (int it = 0; it < 4; ++it) gq[it] = *(const u32x4*)(proj + (row0 + 16 * w + fq + 4 * it) * NP1 + 1024 + h * 128 + 8 * fr);
        bf16x8 qf[2];
#pragma unroll
        for (int ks = 0; ks < 2; ++ks) qf[ks] = lds16(L + RQ_OFF + (16 * w + fr) * 144 + (32 * ks + 8 * fq) * 2);
        f32x4 S[8];
        {
            bf16x8 kf[2][4];
#pragma unroll
            for (int j = 0; j < 4; ++j) kf[0][j] = lds16(L + RK_OFF + (16 * (j >> 1) + fr) * 144 + (32 * (j & 1) + 8 * fq) * 2);
#pragma unroll
            for (int g = 0; g < 4; ++g) {
                if (g < 3) {
#pragma unroll
                    for (int j = 0; j < 4; ++j) kf[(g + 1) & 1][j] = lds16(L + RK_OFF + (16 * (2 * (g + 1) + (j >> 1)) + fr) * 144 + (32 * (j & 1) + 8 * fq) * 2);
                }
                SCHED_FENCE();
#pragma unroll
                for (int j = 0; j < 4; ++j) { const int mb = 2 * g + (j >> 1); if ((j & 1) == 0) S[mb] = (f32x4){0.f, 0.f, 0.f, 0.f}; S[mb] = mfma16(kf[g & 1][j], qf[j & 1], S[mb]); }
                SCHED_FENCE();
            }
#pragma unroll
            for (int mb = 0; mb < 8; ++mb)
#pragma unroll
                for (int i = 0; i < 4; ++i) if (16 * mb + 4 * fq + i > 16 * w + fr) S[mb][i] = 0.f;
        }
        f32x4 acc[8];
        {
            bf16x8 rf_[2][4];
#pragma unroll
            for (int j = 0; j < 4; ++j) rf_[0][j] = lds16(L + RRT_OFF + (16 * ((j >> 1) ^ ebase) + fr) * 144 + (32 * (j & 1) + 8 * fq) * 2);
#pragma unroll
            for (int g = 0; g < 4; ++g) {
                if (g < 3) {
#pragma unroll
                    for (int j = 0; j < 4; ++j) rf_[(g + 1) & 1][j] = lds16(L + RRT_OFF + (16 * ((2 * (g + 1) + (j >> 1)) ^ ebase) + fr) * 144 + (32 * (j & 1) + 8 * fq) * 2);
                }
                SCHED_FENCE();
#pragma unroll
                for (int j = 0; j < 4; ++j) { const int eb = 2 * g + (j >> 1); if ((j & 1) == 0) acc[eb] = (f32x4){0.f, 0.f, 0.f, 0.f}; acc[eb] = mfma16(rf_[g & 1][j], qf[j & 1], acc[eb]); }
                SCHED_FENCE();
            }
#pragma unroll
            for (int eb = 0; eb < 8; ++eb) acc[eb] = acc[eb] * g128;
        }
#pragma unroll
        for (int t = 0; t < 4; ++t) Racc[t] = Racc[t] * g128;
        {
            const int tcol = 4 * (fr & 3);
            s16x4 vb[2][8];
#define RV_LOAD(buf, s_, half_) do { const int trow_ = 32 * (s_) + 4 * fq + (fr >> 2); _Pragma("unroll") for (int e_ = 0; e_ < 4; ++e_) { \
                vb[buf][2 * e_] = ldstr(L + RV_OFF + trow_ * 288 + (16 * ((4 * (half_) + e_) ^ ebase) + tcol) * 2); vb[buf][2 * e_ + 1] = ldstr(L + RV_OFF + (trow_ + 16) * 288 + (16 * ((4 * (half_) + e_) ^ ebase) + tcol) * 2); } } while (0)
            RV_LOAD(0, 0, 0);
#pragma unroll
            for (int s = 0; s < 4; ++s) {
                u32x4 pw; pw.x = pk2(S[2 * s][0], S[2 * s][1]); pw.y = pk2(S[2 * s][2], S[2 * s][3]); pw.z = pk2(S[2 * s + 1][0], S[2 * s + 1][1]); pw.w = pk2(S[2 * s + 1][2], S[2 * s + 1][3]);
                const bf16x8 pf = __builtin_bit_cast(bf16x8, pw);
                const int trow = 32 * s + 4 * fq + (fr >> 2);
                const bf16x8 ktf = cat4(ldstr(L + RK_OFF + trow * 144 + (16 * db + tcol) * 2), ldstr(L + RK_OFF + (trow + 16) * 144 + (16 * db + tcol) * 2));
#pragma unroll
                for (int hf = 0; hf < 2; ++hf) {
                    const int bi = 2 * s + hf;
                    if (bi < 7) RV_LOAD((bi + 1) & 1, (bi + 1) >> 1, (bi + 1) & 1);
                    SCHED_FENCE();
#pragma unroll
                    for (int e = 0; e < 4; ++e) { const int eb = 4 * hf + e; const bf16x8 vf = cat4(vb[bi & 1][2 * e], vb[bi & 1][2 * e + 1]);
                        acc[eb] = mfma16(vf, pf, acc[eb]);
                        if (hf == 0) Racc[e] = mfma16(ktf, vf, Racc[e]); }
                    SCHED_FENCE();
                }
            }
#undef RV_LOAD
        }
        const float rowf = exp2f((float)(16 * w + fr - 127) * lg2);
#pragma unroll
        for (int eb = 0; eb < 8; ++eb) acc[eb] = acc[eb] * rowf;
        headnorm_store(acc, nw, gq, L + RSTG_OFF + w * 4352, mix + (row0 + 16 * w) * DM + h * 128, lane, ebase);
    }
}

constexpr int MQ_OFF = 0, MK_OFF = 34816, MV_OFF = 69632, MCT_OFF = 106496, MCW_OFF = 145664, MGC_OFF = 150784, MGS_OFF = 152320, MNW_OFF = 152704;
DI float logsig_f(float x) { return fminf(x, 0.f) - log1pf(__expf(-fabsf(x))); }
DI void mlstm_item(Frame& F, const Args& a, int b, int h, int midx) {
    const lptr L = F.lds; const int w = F.wave;
    const bf16_t* proj = (const bf16_t*)(F.ws + WS_PROJ); bf16_t* mix = (bf16_t*)(F.ws + WS_MIX);
    const float* gates = (const float*)(F.ws + WS_GATES);
    f32x4* garr = (f32x4*)(F.ws + WS_GARR) + (size_t)midx * SEQ;
    LAS float* cw = (LAS float*)(L + MCW_OFF);
    LAS float* gcu = (LAS float*)(L + MGC_OFF); LAS float* gcr = gcu + 128; LAS float* gcd = gcu + 256;
    LAS float* gs_old = (LAS float*)(L + MGS_OFF); LAS float* gs_loc = gs_old + 16; LAS float* gs_rat = gs_old + 32; LAS float* gs_M = gs_old + 48; LAS float* gs_bt = gs_old + 64; LAS float* gs_mp = gs_old + 80;
    LAS float* nw = (LAS float*)(L + MNW_OFF);
    {
        const int lane = lane_id(), tid = w * 64 + lane;
        for (int i = tid; i < 39168 / 16; i += NTHR) *(LAS u32x4*)(L + MCT_OFF + i * 16) = (u32x4){0u, 0u, 0u, 0u};
        if (tid < 128) { *(LAS u32x4*)(L + MV_OFF + tid * 288 + 256) = (u32x4){0x00003F80u, 0u, 0u, 0u}; *(LAS u32x4*)(L + MV_OFF + tid * 288 + 272) = (u32x4){0u, 0u, 0u, 0u};
#pragma unroll
            for (int j = 0; j < 4; ++j) { cw[j * 128 + tid] = a.in[5][j * 1024 + h * 128 + tid]; cw[640 + j * 128 + tid] = a.in[5][j * 1024 + 512 + h * 128 + tid]; }
            cw[512 + tid] = a.in[6][h * 128 + tid]; cw[640 + 512 + tid] = a.in[6][512 + h * 128 + tid]; nw[tid] = a.in[8][h * 128 + tid]; }
        LAS float* tb = (LAS float*)L; LAS float* tg = tb + 2048; LAS float* tpm = tb + 4096;
#pragma unroll
        for (int cc = 0; cc < 2; ++cc) {
            const int c = 2 * w + cc; const float* gp = gates + ((size_t)b * SEQ + c * 128 + 2 * lane) * 8;
            const float ig0 = gp[h], ig1 = gp[8 + h]; const float lf0 = logsig_f(gp[4 + h]), lf1 = logsig_f(gp[12 + h]);
            float incl = lf0 + lf1;
#pragma unroll
            for (int o = 1; o < 64; o <<= 1) { const float t = __shfl_up(incl, o); if (lane >= o) incl += t; }
            const float b1 = incl, b0 = incl - lf1;
            const float g0 = ig0 - b0, g1 = ig1 - b1;
            float pmi = fmaxf(g0, g1);
#pragma unroll
            for (int o = 1; o < 64; o <<= 1) { const float t = __shfl_up(pmi, o); if (lane >= o) pmi = fmaxf(pmi, t); }
            float pme = __shfl_up(pmi, 1); if (lane == 0) pme = -INFINITY;
            const int r = c * 128 + 2 * lane;
            tb[r] = b0; tb[r + 1] = b1; tg[r] = g0; tg[r + 1] = g1; tpm[r] = fmaxf(pme, g0); tpm[r + 1] = pmi;
            if (lane == 63) { gs_M[c] = pmi; gs_bt[c] = incl; }
        }
        __syncthreads();
        if (tid == 0) { float mprev = 0.f;
            for (int c = 0; c < 16; ++c) { const float M = gs_M[c], bt = gs_bt[c]; gs_mp[c] = mprev; const float mloc = bt + M, mnew = fmaxf(bt + mprev, mloc);
                gs_old[c] = __expf(bt + mprev - mnew); gs_loc[c] = __expf(mloc - mnew); gs_rat[c] = __expf(fminf(mprev - M, 80.f)); mprev = mnew; } }
        __syncthreads();
#pragma unroll
        for (int k = 0; k < 4; ++k) { const int r = tid + NTHR * k, c = r >> 7; const float bb = tb[r], M = gs_M[c]; const float mt = bb + fmaxf(tpm[r], gs_mp[c]);
            garr[r] = (f32x4){__expf(tg[r] - M), __expf(bb + M - mt), __expf(-mt), 0.f}; }
        __syncthreads();
    }
    f32x4 C[9];
#pragma unroll
    for (int t = 0; t < 9; ++t) C[t] = (f32x4){0.f, 0.f, 0.f, 0.f};
    u32x4 vv[4], xr[11]; f32x4 ga = {0.f, 0.f, 0.f, 0.f};
#define ML_LOADX(cidx) do { const size_t rown_ = (size_t)b * SEQ + (size_t)(cidx) * 128; const int col_ = 1536 + (w >= 4 ? 512 : 0) + h * 128 + 8 * cgp; \
        _Pragma("unroll") for (int rr = 0; rr < 11; ++rr) { const int lr = 8 * rb8 + rr - 3; const bool ok_ = ((cidx) > 0) || (lr >= 0); \
            xr[rr] = ok_ ? *(const u32x4*)(proj + (size_t)((long)rown_ + lr) * NP1 + col_) : (u32x4){0u, 0u, 0u, 0u}; } } while (0)
#define ML_LOADS(cidx) do { const size_t rown_ = (size_t)b * SEQ + (size_t)(cidx) * 128; \
        _Pragma("unroll") for (int i = 0; i < 4; ++i) { const int p = tid + i * NTHR, r = p >> 4, ch = p & 15; vv[i] = *(const u32x4*)(proj + (rown_ + r) * NP1 + 2560 + h * 128 + ch * 8); } \
        if (tid < 128) ga = garr[(cidx) * 128 + tid]; } while (0)
    { const int tid = w * 64 + lane_id(), cgp = tid & 15, rb8 = (tid & 255) >> 4; ML_LOADS(0); ML_LOADX(0); }
    for (int c = 0; c < 16; ++c) {
        const size_t row0 = (size_t)b * SEQ + c * 128;
        int tid = F.wave * 64 + lane_id(); asm volatile("" : "+v"(tid));
        const int lane = tid & 63, fr = lane & 15, fq = lane >> 4, cgp = tid & 15, rb8 = (tid & 255) >> 4;
        __syncthreads();
        if (c > 0) {
#pragma unroll
            for (int eb = 0; eb < 9; ++eb) { u32x2 pk; pk.x = pk2(C[eb][0], C[eb][1]); pk.y = pk2(C[eb][2], C[eb][3]);
                *(LAS u32x2*)(L + MCT_OFF + (16 * eb + fr) * 272 + (16 * w + 4 * fq) * 2) = pk; }
        }
#pragma unroll
        for (int i = 0; i < 4; ++i) { const int p = tid + i * NTHR, r = p >> 4, ch = p & 15; *(LAS u32x4*)(L + MV_OFF + r * 288 + ch * 16) = vv[i]; }
        if (tid < 128) { gcu[tid] = ga[0]; gcr[tid] = ga[1]; gcd[tid] = ga[2]; }
        {
            const int isk = (w >= 4) ? 1 : 0; f32x2 wv[4][4], bv[4];
#pragma unroll
            for (int j = 0; j < 5; ++j) { const f32x4 w0 = *(const LAS f32x4*)(cw + isk * 640 + j * 128 + 8 * cgp), w1 = *(const LAS f32x4*)(cw + isk * 640 + j * 128 + 8 * cgp + 4);
                if (j < 4) { wv[j][0] = (f32x2){w0[0], w0[1]}; wv[j][1] = (f32x2){w0[2], w0[3]}; wv[j][2] = (f32x2){w1[0], w1[1]}; wv[j][3] = (f32x2){w1[2], w1[3]}; }
                else { bv[0] = (f32x2){w0[0], w0[1]}; bv[1] = (f32x2){w0[2], w0[3]}; bv[2] = (f32x2){w1[0], w1[1]}; bv[3] = (f32x2){w1[2], w1[3]}; } }
            const float osc = isk ? 0.08838834764831845f : 1.f;
            const lptr tile = L + (isk ? MK_OFF : MQ_OFF) + cgp * 16;
            f32x2 xf[11][4];
#pragma unroll
            for (int rr = 0; rr < 11; ++rr)
#pragma unroll
                for (int p = 0; p < 4; ++p) xf[rr][p] = (f32x2){bflo(xr[rr][p]), bfhi(xr[rr][p])};
#pragma unroll
            for (int r = 0; r < 8; ++r) { u32x4 o;
#pragma unroll
                for (int p = 0; p < 4; ++p) { f32x2 acc_ = bv[p];
#pragma unroll
                    for (int j = 0; j < 4; ++j) acc_ = __builtin_elementwise_fma(wv[j][p], xf[r + j][p], acc_);
                    o[p] = pk2(silu_f(acc_[0]) * osc, silu_f(acc_[1]) * osc); }
                *(LAS u32x4*)(tile + (8 * rb8 + r) * 272) = o; }
        }
        __syncthreads();
        { const int cn = c < 15 ? c + 1 : c; ML_LOADS(cn); }
        const size_t grow = row0 + 16 * w + fr;
        u32x4 gq[4];
#pragma unroll
        for (int it = 0; it < 4; ++it) gq[it] = *(const u32x4*)(proj + (row0 + 16 * w + fq + 4 * it) * NP1 + 3072 + h * 128 + 8 * fr);
        bf16x8 qf[4];
#pragma unroll
        for (int ks = 0; ks < 4; ++ks) qf[ks] = lds16(L + MQ_OFF + (16 * w + fr) * 272 + (32 * ks + 8 * fq) * 2);
        const float so = gs_old[c], sl = gs_loc[c], rat = gs_rat[c];
        f32x4 acc[9];
        {
            bf16x8 cf[2][4];
#pragma unroll
            for (int ks = 0; ks < 4; ++ks) cf[0][ks] = lds16(L + MCT_OFF + fr * 272 + (32 * ks + 8 * fq) * 2);
#pragma unroll
            for (int eb = 0; eb < 9; ++eb) {
                if (eb < 8) {
#pragma unroll
                    for (int ks = 0; ks < 4; ++ks) cf[(eb + 1) & 1][ks] = lds16(L + MCT_OFF + (16 * (eb + 1) + fr) * 272 + (32 * ks + 8 * fq) * 2);
                }
                SCHED_FENCE();
                acc[eb] = (f32x4){0.f, 0.f, 0.f, 0.f};
#pragma unroll
                for (int ks = 0; ks < 4; ++ks) acc[eb] = mfma16(cf[eb & 1][ks], qf[ks], acc[eb]);
                SCHED_FENCE();
            }
#pragma unroll
            for (int eb = 0; eb < 9; ++eb) { acc[eb] = acc[eb] * rat; C[eb] = C[eb] * so; }
        }
        {
            const int tcol = 4 * (fr & 3);
            s16x4 vb[2][6];
#define MV_LOAD(buf, s_, g_) do { const int trow_ = 32 * (s_) + 4 * fq + (fr >> 2); _Pragma("unroll") for (int e_ = 0; e_ < 3; ++e_) { \
                vb[buf][2 * e_] = ldstr(L + MV_OFF + trow_ * 288 + (16 * (3 * (g_) + e_) + tcol) * 2); vb[buf][2 * e_ + 1] = ldstr(L + MV_OFF + (trow_ + 16) * 288 + (16 * (3 * (g_) + e_) + tcol) * 2); } } while (0)
#pragma unroll
            for (int hf = 0; hf < 2; ++hf) {
                f32x4 S[4];
                {
                    bf16x8 kf[2][4];
#pragma unroll
                    for (int ks = 0; ks < 4; ++ks) kf[0][ks] = lds16(L + MK_OFF + (64 * hf + fr) * 272 + (32 * ks + 8 * fq) * 2);
#pragma unroll
                    for (int sq = 0; sq < 4; ++sq) {
                        if (sq < 3) {
#pragma unroll
                            for (int ks = 0; ks < 4; ++ks) kf[(sq + 1) & 1][ks] = lds16(L + MK_OFF + (64 * hf + 16 * (sq + 1) + fr) * 272 + (32 * ks + 8 * fq) * 2);
                        } else { MV_LOAD(0, 2 * hf, 0); }
                        SCHED_FENCE();
                        S[sq] = (f32x4){0.f, 0.f, 0.f, 0.f};
#pragma unroll
                        for (int ks = 0; ks < 4; ++ks) S[sq] = mfma16(kf[sq & 1][ks], qf[ks], S[sq]);
                        SCHED_FENCE();
                    }
                }
#pragma unroll
                for (int sq = 0; sq < 4; ++sq) { const int sb = 4 * hf + sq; const f32x4 u4 = *(const LAS f32x4*)(gcu + 16 * sb + 4 * fq);
#pragma unroll
                    for (int i = 0; i < 4; ++i) S[sq][i] = (16 * sb + 4 * fq + i > 16 * w + fr) ? 0.f : S[sq][i] * u4[i]; }
#pragma unroll
                for (int s2 = 0; s2 < 2; ++s2) { const int s = 2 * hf + s2;
                    u32x4 pw; pw.x = pk2(S[2 * s2][0], S[2 * s2][1]); pw.y = pk2(S[2 * s2][2], S[2 * s2][3]); pw.z = pk2(S[2 * s2 + 1][0], S[2 * s2 + 1][1]); pw.w = pk2(S[2 * s2 + 1][2], S[2 * s2 + 1][3]);
                    const bf16x8 pf = __builtin_bit_cast(bf16x8, pw);
                    const int trow = 32 * s + 4 * fq + (fr >> 2);
                    u32x4 kt = __builtin_bit_cast(u32x4, cat4(ldstr(L + MK_OFF + trow * 272 + (16 * w + tcol) * 2), ldstr(L + MK_OFF + (trow + 16) * 272 + (16 * w + tcol) * 2)));
                    const f32x4 ua = *(const LAS f32x4*)(gcu + 32 * s + 4 * fq) * sl, ub = *(const LAS f32x4*)(gcu + 32 * s + 16 + 4 * fq) * sl;
                    kt.x = pk2(bflo(kt.x) * ua[0], bfhi(kt.x) * ua[1]); kt.y = pk2(bflo(kt.y) * ua[2], bfhi(kt.y) * ua[3]); kt.z = pk2(bflo(kt.z) * ub[0], bfhi(kt.z) * ub[1]); kt.w = pk2(bflo(kt.w) * ub[2], bfhi(kt.w) * ub[3]);
                    const bf16x8 ktf = __builtin_bit_cast(bf16x8, kt);
#pragma unroll
                    for (int g = 0; g < 3; ++g) { const int bi = 3 * s2 + g;
                        if (bi < 5) MV_LOAD((bi + 1) & 1, 2 * hf + (bi + 1) / 3, (bi + 1) % 3);
                        SCHED_FENCE();
#pragma unroll
                        for (int e = 0; e < 3; ++e) { const int eb = 3 * g + e; const bf16x8 vf = cat4(vb[bi & 1][2 * e], vb[bi & 1][2 * e + 1]);
                            acc[eb] = mfma16(vf, pf, acc[eb]);
                            C[eb] = mfma16(ktf, vf, C[eb]); }
                        SCHED_FENCE();
                    }
                }
            }
#undef MV_LOAD
        }
        { const int cn = c < 15 ? c + 1 : c; ML_LOADX(cn); }
        {
            const int t = 16 * w + fr; const float rf = gcr[t], dc = gcd[t];
            float den = rf * acc[8][0]; den = __shfl(den, fr);
            const float sc = rf / fmaxf(fabsf(den), dc);
            f32x4 hv[8];
#pragma unroll
            for (int eb = 0; eb < 8; ++eb) hv[eb] = acc[eb] * sc;
            headnorm_store(hv, nw, gq, L + MQ_OFF + 16 * w * 272, mix + (row0 + 16 * w) * DM + 512 + h * 128, lane, 0);
        }
    }
#undef ML_LOADS
#undef ML_LOADX
}
constexpr int MW_SPLIT = 18432;
struct MwItem { const float* W; bf16_t* WT; const float* ks; int ldn, K, k0, n0, mode; };
DI MwItem mw_decode(const Args& a, unsigned char* ws, int it) {
    constexpr int I_GU = 32 * 16 * 16;
    MwItem m; const int sec = it / I_GU, r = it - sec * I_GU, e = r >> 8, q = r & 255;
    if (sec < 2) { m.W = a.in[20 + sec] + (size_t)e * DM * DEXP; m.WT = (bf16_t*)(ws + WS_W1 + (size_t)e * 1024 * DM); m.ks = a.in[15]; m.ldn = DEXP; m.K = DM; m.k0 = 64 * (q >> 4); m.n0 = 32 * (q & 15); }
    else { m.W = a.in[22] + (size_t)e * DEXP * DM; m.WT = (bf16_t*)(ws + WS_W2 + (size_t)e * DM * DEXP); m.ks = nullptr; m.ldn = DM; m.K = DEXP; m.k0 = 64 * (q >> 5); m.n0 = 32 * (q & 31); }
    m.mode = sec; return m;
}
DI void mw_load(const MwItem& m, int lane, f32x4 (&v)[8], float (&ksc)[8]) {
    const int r8 = lane >> 3, c4 = (lane & 7) * 4;
#pragma unroll
    for (int i = 0; i < 8; ++i) { v[i] = *(const f32x4*)(m.W + (size_t)(m.k0 + r8 + 8 * i) * m.ldn + m.n0 + c4); ksc[i] = m.ks ? m.ks[m.k0 + r8 + 8 * i] : 1.f; }
}
DI void mw_store(const MwItem& m, int lane, LAS float* scr, const f32x4 (&v)[8], const float (&ksc)[8]) {
    const int r8 = lane >> 3, c4 = (lane & 7) * 4;
#pragma unroll
    for (int i = 0; i < 8; ++i) { LAS float* d = scr + (r8 + 8 * i) * 33 + c4; d[0] = v[i][0] * ksc[i]; d[1] = v[i][1] * ksc[i]; d[2] = v[i][2] * ksc[i]; d[3] = v[i][3] * ksc[i]; }
    asm volatile("s_waitcnt lgkmcnt(0)" ::: "memory");
    const int c = lane & 7;
#pragma unroll
    for (int j = 0; j < 4; ++j) { const int nl = (lane >> 3) + 8 * j, n = m.n0 + nl; const LAS float* s = scr + (8 * c) * 33 + nl;
        const long orow = (m.mode < 2) ? (long)(n >> 7) * 256 + m.mode * 128 + (n & 127) : n;
        const float sc = (m.mode < 2) ? 32.f : 16.f;
        u32x2 o; o.x = pk4_fp8(s[0 * 33] * sc, s[1 * 33] * sc, s[2 * 33] * sc, s[3 * 33] * sc); o.y = pk4_fp8(s[4 * 33] * sc, s[5 * 33] * sc, s[6 * 33] * sc, s[7 * 33] * sc);
        *(u32x2*)((unsigned char*)m.WT + (size_t)orow * m.K + m.k0 + 8 * c) = o; }
    asm volatile("s_waitcnt lgkmcnt(0)" ::: "memory");
}
DI void moe_weight_items(Frame& F, const Args& a, int wi, int nw, int it_lo, int it_hi) {
    LAS float* scr = (LAS float*)(F.lds + F.wave * 16384);
    const int lane = lane_id(); unsigned char* ws = F.ws;
    const int NIT = it_hi;
    if (it_lo + wi >= NIT) return;
    MwItem cur = mw_decode(a, ws, it_lo + wi); f32x4 v[8]; float ksc[8];
    mw_load(cur, lane, v, ksc);
    for (int it = it_lo + wi; it < NIT; it += nw) {
        const int itn = (it + nw < NIT) ? it + nw : it;
        const MwItem nxt = mw_decode(a, ws, itn); f32x4 vn[8]; float kn[8];
        mw_load(nxt, lane, vn, kn);
        mw_store(cur, lane, scr, v, ksc);
        cur = nxt;
#pragma unroll
        for (int i = 0; i < 8; ++i) { v[i] = vn[i]; ksc[i] = kn[i]; }
    }
}
DI void p2_mixer(Frame& F, const Args& a) {
    const int nret = (F.G + 1) / 2;
    for (int item = F.vcu; item < 256; item += F.G) {
        const int b = item >> 3, h = (item >> 1) & 3;
        if (item & 1) mlstm_item(F, a, b, h, item >> 1); else ret_item(F, a, b, h);
        __syncthreads();
    }
    if ((F.vcu & 1) == 0) {
        const int rc = F.vcu >> 1;
        SchedKV S; S.first = rc; S.step = nret; S.A = (const char*)(F.ws + WS_MEMN); S.B = (const char*)(F.ws + WS_WKV);
        EpiKV8 E{F.ws + WS_KV};
        pg8::gemm_phase<EpiKV8, SchedKV, false, true>(F.lds, DM, S, E, F.wave, 122);
        __syncthreads();
        moe_weight_items(F, a, rc * NWAVES + F.wave, nret * NWAVES, 0, MW_SPLIT);
    }
}

struct EpiP4 {
    static constexpr int NPRE = 0;
    const float* ssq; unsigned char* q;
    DI void operator()(const f32x4 (&acc)[2][2][4][2], const pg8::Unit& u, int wr, int wc, int fr, int fq) const {
        asm volatile("" : "+v"(fr), "+v"(fq));
        const int row0 = u.pm * 256 + wr * 64 + fr, col0 = u.pn * 256 + wc * 32 + 8 * fq;
        f32x4 sp[2][4];
#pragma unroll
        for (int ai = 0; ai < 2; ++ai)
#pragma unroll
            for (int m = 0; m < 4; ++m) sp[ai][m] = *((const f32x4*)(ssq + (size_t)(row0 + ai * 128 + m * 16) * 16) + fq);
        SCHED_FENCE();
#pragma unroll
        for (int ai = 0; ai < 2; ++ai)
#pragma unroll
            for (int m = 0; m < 4; ++m) {
                const int grow = row0 + ai * 128 + m * 16;
                float tot = (sp[ai][m][0] + sp[ai][m][1]) + (sp[ai][m][2] + sp[ai][m][3]); tot += __shfl_xor(tot, 16); tot += __shfl_xor(tot, 32);
                const float rstd = rsqrtf(tot * (1.f / DM) + EPS);
#pragma unroll
                for (int bj = 0; bj < 2; ++bj) { const f32x4 v0 = acc[ai][bj][m][0] * rstd, v1 = acc[ai][bj][m][1] * rstd;
                    u32x2 w; w.x = pk4_fp8(v0[0], v0[1], v0[2], v0[3]); w.y = pk4_fp8(v1[0], v1[1], v1[2], v1[3]);
                    *(u32x2*)(q + (size_t)grow * DM + col0 + bj * 128) = w; }
            }
    }
};
struct EpiP6 {
    static constexpr int NPRE = 0;
    const bf16_t* x1b; bf16_t* x2b; unsigned char* xq8;
    DI void operator()(const f32x4 (&acc)[2][2][4][2], const pg8::Unit& u, int wr, int wc, int fr, int fq) const {
        asm volatile("" : "+v"(fr), "+v"(fq));
        const int row0 = u.pm * 256 + wr * 64 + fr, col0 = u.pn * 256 + wc * 32 + 8 * fq;
        u32x4 rv[2][4][2];
#pragma unroll
        for (int ai = 0; ai < 2; ++ai)
#pragma unroll
            for (int m = 0; m < 4; ++m)
#pragma unroll
                for (int bj = 0; bj < 2; ++bj) rv[ai][m][bj] = *(const u32x4*)(x1b + (size_t)(row0 + ai * 128 + m * 16) * DM + col0 + bj * 128);
        SCHED_FENCE();
#pragma unroll
        for (int ai = 0; ai < 2; ++ai)
#pragma unroll
            for (int m = 0; m < 4; ++m) {
                const int grow = row0 + ai * 128 + m * 16;
#pragma unroll
                for (int bj = 0; bj < 2; ++bj) { const size_t off = (size_t)grow * DM + col0 + bj * 128; const u32x4 r = rv[ai][m][bj];
                    const f32x4 v0 = acc[ai][bj][m][0], v1 = acc[ai][bj][m][1];
                    u32x4 w; w.x = pk2(v0[0] + bflo(r.x), v0[1] + bfhi(r.x)); w.y = pk2(v0[2] + bflo(r.y), v0[3] + bfhi(r.y)); w.z = pk2(v1[0] + bflo(r.z), v1[1] + bfhi(r.z)); w.w = pk2(v1[2] + bflo(r.w), v1[3] + bfhi(r.w));
                    *(u32x4*)(x2b + off) = w;
                    u32x2 w8; w8.x = pk4_fp8(v0[0] + bflo(r.x), v0[1] + bfhi(r.x), v0[2] + bflo(r.y), v0[3] + bfhi(r.y)); w8.y = pk4_fp8(v1[0] + bflo(r.z), v1[1] + bfhi(r.z), v1[2] + bflo(r.w), v1[3] + bfhi(r.w));
                    *(u32x2*)(xq8 + off) = w8; }
            }
    }
};

typedef float f32x16 __attribute__((ext_vector_type(16)));
DI f32x16 mfma32(bf16x8 a, bf16x8 b, f32x16 c) { return __builtin_amdgcn_mfma_f32_32x32x16_bf16(a, b, c, 0, 0, 0); }
constexpr int ARING = 36864;
template <int STRIDE, int ROWB, int NROWS, bool KPERM>
DI void attn_dma5(lptr L, int slot, const bf16_t* src, int w) {
    const int l16 = 16 * lane_id_v();
    const int q0 = l16 / STRIDE, r0 = l16 - q0 * STRIDE;
    constexpr int NCH = NROWS * STRIDE / 1024;
#pragma unroll
    for (int i = 0; i < 5; ++i) {
        int k = w + 8 * i; k = k < NCH ? k : NCH - 1;
        const int Q = (1024 * k) / STRIDE, R = 1024 * k - Q * STRIDE;
        int cb = R + r0, row = Q + q0; if (cb >= STRIDE) { cb -= STRIDE; row += 1; }
        if (KPERM) row = (row & ~12) | ((row & 4) << 1) | ((row & 8) >> 1);
        const unsigned off = (cb < ROWB) ? (unsigned)(row * 256 + (cb >> 1)) : 0u;
        __builtin_amdgcn_global_load_lds((const unsigned*)(src + off), (LAS unsigned*)(L + slot * ARING + 1024 * k), 16, 0, 0);
    }
}
DI bf16x8 fp8x8_to_bf16(u32x2 r) {
    const f32x2 a = __builtin_amdgcn_cvt_pk_f32_fp8((int)r.x, false), b = __builtin_amdgcn_cvt_pk_f32_fp8((int)r.x, true), c = __builtin_amdgcn_cvt_pk_f32_fp8((int)r.y, false), d = __builtin_amdgcn_cvt_pk_f32_fp8((int)r.y, true);
    u32x4 w; w.x = pk2(a[0], a[1]); w.y = pk2(b[0], b[1]); w.z = pk2(c[0], c[1]); w.w = pk2(d[0], d[1]);
    return __builtin_bit_cast(bf16x8, w);
}
template <int DBG> DI void attn_phase(Frame& F) {
    const lptr L = F.lds; const int w = F.wave;
    const unsigned char* q8 = F.ws + WS_Q; const bf16_t* kv = (const bf16_t*)(F.ws + WS_KV); unsigned char* o8 = F.ws + WS_O;
    constexpr int NU = 1024;
    constexpr bool d_nodma = DBG & 1;
    const lptr stg = L + w * 8704;
#define AT_ISSUE(m_) do { if (d_nodma) break; const bf16_t* base_ = kv + ((size_t)bh << 16); \
        if ((m_) < 4) attn_dma5<528, 512, 64, true>(L, ((m_) + 2) & 3, base_ + 64 * (m_) * 256, w); else attn_dma5<144, 128, 256, false>(L, ((m_) + 2) & 3, base_ + ((size_t)NB * 4 << 16) + 64 * ((m_) - 4), w); } while (0)
#define AT_WAIT(m_) do { if ((m_) <= 5) asm volatile("s_waitcnt vmcnt(10)" ::: "memory"); else if ((m_) == 6) asm volatile("s_waitcnt vmcnt(5)" ::: "memory"); else asm volatile("s_waitcnt vmcnt(8)" ::: "memory"); \
        __builtin_amdgcn_s_barrier(); asm volatile("" ::: "memory"); } while (0)
#define AT_QROWS(u_) do { const int u__ = (u_), bh__ = u__ >> 3; const int l__ = lane_id_v(); \
        const unsigned char* src__ = q8 + ((size_t)(bh__ >> 2) * SEQ + (u__ & 7) * 256 + 32 * w + (l__ >> 4)) * DM + (bh__ & 3) * 256 + 16 * (l__ & 15); \
        _Pragma("unroll") for (int it = 0; it < 8; ++it) asm volatile("global_load_dwordx4 %0, %1, off" : "=v"(qt_[it]) : "v"(src__ + (size_t)(4 * it) * DM) : "memory"); } while (0)
    u32x4 qt_[8];
    if (F.vcu < NU) AT_QROWS(F.vcu);
    for (int u = F.vcu; u < NU; u += F.G) {
        const int bh = u >> 3, qt = u & 7, b = bh >> 2, h = bh & 3;
        const int ln_ = lane_id_v();
        const int lr = ln_ & 31, lh = ln_ >> 5;
        const size_t row0 = (size_t)b * SEQ + qt * 256 + 32 * w;
        AT_ISSUE(0); AT_ISSUE(1);
        if (u == F.vcu) asm volatile("s_waitcnt vmcnt(10)" ::: "memory"); else asm volatile("s_waitcnt vmcnt(18)" ::: "memory");
#pragma unroll
        for (int it = 0; it < 8; ++it) *(LAS u32x4*)(stg + (4 * it + (ln_ >> 4)) * 272 + 16 * (ln_ & 15)) = qt_[it];
        bf16x8 qf[16];
#pragma unroll
        for (int ks = 0; ks < 16; ++ks) qf[ks] = fp8x8_to_bf16(*(const LAS u32x2*)(stg + lr * 272 + 16 * ks + 8 * lh));
        asm volatile("s_waitcnt lgkmcnt(0)" ::: "memory");
        __builtin_amdgcn_s_barrier(); asm volatile("" ::: "memory");
        AT_ISSUE(2);
        f32x16 S[8];
        bf16x8 kfA[4], kfB[4];
#define AT_LDS16(d_, a_) asm volatile("ds_read_b128 %0, %1" : "=v"(d_) : "v"(a_) : "memory")
#define AT_LWAIT(n_, f_) asm volatile("s_waitcnt lgkmcnt(" #n_ ")" : "+v"(f_[0]), "+v"(f_[1]), "+v"(f_[2]), "+v"(f_[3]) :: "memory")
#define AT_KREAD(dst_, i_) do { const unsigned kb_ = (unsigned)(size_t)L + ((((i_) >> 3) + 2) & 3) * ARING + lr * 528 + lh * 16 + (((i_) & 7) >> 2) * 32 * 528 + 128 * ((i_) & 3); \
        _Pragma("unroll") for (int jj = 0; jj < 4; ++jj) AT_LDS16(dst_[jj], kb_ + 32 * jj); } while (0)
#define AT_KMMA(src_, i_) do { const int blk_ = 2 * ((i_) >> 3) + (((i_) & 7) >> 2); \
        if (((i_) & 3) == 0) { _Pragma("unroll") for (int i = 0; i < 16; ++i) S[blk_][i] = 0.f; } \
        _Pragma("unroll") for (int jj = 0; jj < 4; ++jj) S[blk_] = mfma32(src_[jj], qf[4 * ((i_) & 3) + jj], S[blk_]); } while (0)
#define AT_KNEXT(dst_, cur_, i_) do { if ((i_) < 32) { if (((i_) & 7) == 0) { AT_LWAIT(0, cur_); AT_WAIT((i_) >> 3); AT_ISSUE(((i_) >> 3) + 3); } AT_KREAD(dst_, (i_)); AT_LWAIT(4, cur_); } else AT_LWAIT(0, cur_); } while (0)
        AT_WAIT(0); AT_ISSUE(3);
        AT_KREAD(kfA, 0);
#pragma unroll
        for (int i2 = 0; i2 < 32; i2 += 2) {
            AT_KNEXT(kfB, kfA, i2 + 1); SCHED_FENCE(); AT_KMMA(kfA, i2); SCHED_FENCE();
            AT_KNEXT(kfA, kfB, i2 + 2); SCHED_FENCE(); AT_KMMA(kfB, i2 + 1); SCHED_FENCE();
        }
        bf16x8 pf[8][2]; float inv;
        {
            float mx = -INFINITY;
#pragma unroll
            for (int blk = 0; blk < 8; ++blk)
#pragma unroll
                for (int i = 0; i < 16; i += 2) mx = fmaxf(mx, fmaxf(S[blk][i], S[blk][i + 1]));
            { auto rr = __builtin_amdgcn_permlane32_swap(__float_as_uint(mx), __float_as_uint(mx), false, false); mx = fmaxf(__uint_as_float(rr[0]), __uint_as_float(rr[1])); }
            float sum = 0.f;
#pragma unroll
            for (int blk = 0; blk < 8; ++blk)
#pragma unroll
                for (int s_ = 0; s_ < 2; ++s_) { float p[8];
#pragma unroll
                    for (int i = 0; i < 8; ++i) p[i] = __builtin_amdgcn_exp2f(S[blk][8 * s_ + i] - mx);
                    sum += ((p[0] + p[1]) + (p[2] + p[3])) + ((p[4] + p[5]) + (p[6] + p[7]));
                    u32x4 pw; pw.x = pk2(p[0], p[1]); pw.y = pk2(p[2], p[3]); pw.z = pk2(p[4], p[5]); pw.w = pk2(p[6], p[7]);
                    pf[blk][s_] = __builtin_bit_cast(bf16x8, pw); }
            { auto rr = __builtin_amdgcn_permlane32_swap(__float_as_uint(sum), __float_as_uint(sum), false, false); sum = __uint_as_float(rr[0]) + __uint_as_float(rr[1]); }
            inv = __builtin_amdgcn_rcpf(sum);
        }
        f32x16 O[8];
#pragma unroll
        for (int eb = 0; eb < 8; ++eb)
#pragma unroll
            for (int i = 0; i < 16; ++i) O[eb][i] = 0.f;
        {
            bf16x8 vfA[4], vfB[4];
#define AT_VREAD(dst_, i_) do { const unsigned vb_ = (unsigned)(size_t)L + ((((i_) >> 3) + 2) & 3) * ARING + lr * 144 + lh * 16 + ((i_) & 7) * 32 * 144; \
        _Pragma("unroll") for (int kk = 0; kk < 4; ++kk) AT_LDS16(dst_[kk], vb_ + 32 * kk); } while (0)
#define AT_VMMA(src_, i_) do { _Pragma("unroll") for (int kk = 0; kk < 4; ++kk) O[(i_) & 7] = mfma32(src_[kk], pf[2 * ((i_) >> 3) + (kk >> 1)][kk & 1], O[(i_) & 7]); } while (0)
#define AT_VNEXT(dst_, cur_, i_) do { if ((i_) < 32) { if (((i_) & 7) == 0) { AT_LWAIT(0, cur_); AT_WAIT(4 + ((i_) >> 3)); \
        if (((i_) >> 3) == 2) { const int un = u + F.G; AT_QROWS(un < NU ? un : u); } }     \
        AT_VREAD(dst_, (i_)); AT_LWAIT(4, cur_); } else AT_LWAIT(0, cur_); } while (0)
            AT_WAIT(4); AT_ISSUE(7);
            AT_VREAD(vfA, 0);
#pragma unroll
            for (int i2 = 0; i2 < 32; i2 += 2) {
                AT_VNEXT(vfB, vfA, i2 + 1); SCHED_FENCE(); AT_VMMA(vfA, i2); SCHED_FENCE();
                AT_VNEXT(vfA, vfB, i2 + 2); SCHED_FENCE(); AT_VMMA(vfB, i2 + 1); SCHED_FENCE();
            }
        }
        __builtin_amdgcn_s_barrier(); asm volatile("" ::: "memory");
        {
            const int ln2 = lane_id_v(); const int r2 = ln2 & 31, h2 = ln2 >> 5; const float sc16 = inv * 16.f;
#pragma unroll
            for (int eb = 0; eb < 8; ++eb)
#pragma unroll
                for (int g = 0; g < 4; ++g) *(LAS unsigned*)(stg + r2 * 272 + 32 * eb + 8 * g + 4 * h2) = pk4_fp8(O[eb][4 * g] * sc16, O[eb][4 * g + 1] * sc16, O[eb][4 * g + 2] * sc16, O[eb][4 * g + 3] * sc16);
            asm volatile("s_waitcnt lgkmcnt(0)" ::: "memory");
#pragma unroll
            for (int it = 0; it < 8; ++it) { const int rr = 4 * it + (ln2 >> 4), ch = ln2 & 15; const u32x4 v = *(const LAS u32x4*)(stg + rr * 272 + 16 * ch);
                *(u32x4*)(o8 + (row0 + rr) * DM + h * 256 + 16 * ch) = v; }
            asm volatile("s_waitcnt lgkmcnt(0)" ::: "memory");
        }
    }
    asm volatile("s_waitcnt vmcnt(0)" ::: "memory");
    __syncthreads();
#undef AT_ISSUE
#undef AT_WAIT
#undef AT_QROWS
#undef AT_KREAD
#undef AT_LDS16
#undef AT_LWAIT
#undef AT_KMMA
#undef AT_KNEXT
#undef AT_VREAD
#undef AT_VMMA
#undef AT_VNEXT
}

typedef unsigned u32x8 __attribute__((ext_vector_type(8)));
DI void mfma8_32(f32x16& acc, const u32x8& a, const u32x8& b, int sa, int sb) {
    asm volatile("s_nop 1\n\tv_mfma_scale_f32_32x32x64_f8f6f4 %0, %1, %2, %0, %3, %4 op_sel_hi:[0,0,0]" : "+v"(acc) : "v"(a), "v"(b), "v"(sa), "v"(sb));
}
DI u32x8 lds32(lptr p) { return __builtin_shufflevector(*(const LAS u32x4*)p, *(const LAS u32x4*)(p + 16), 0, 1, 2, 3, 4, 5, 6, 7); }
template <bool KPERM>
DI void attn8_img_dma(lptr dst, const unsigned char* src, int w) {
    const int l16 = 16 * lane_id_v(); const int q0 = l16 / 272, r0 = l16 - q0 * 272;
#pragma unroll
    for (int i = 0; i < 9; ++i) {
        int k = w + 8 * i; k = k < 68 ? k : 67;
        const int Q = (1024 * k) / 272, R = 1024 * k - Q * 272;
        int cb = R + r0, row = Q + q0; if (cb >= 272) { cb -= 272; row += 1; }
        if (KPERM) row = (row & ~63) | (((row >> 2) & 1) << 5) | (((row >> 5) & 1) << 4) | (((row >> 3) & 3) << 2) | (row & 3);
        const unsigned off = (cb < 256) ? (unsigned)(row * 256 + cb) : 0u;
        __builtin_amdgcn_global_load_lds((const unsigned*)(src + off), (LAS unsigned*)(dst + 1024 * k), 16, 0, 0);
    }
}
DI void attn8_phase(Frame& F) {
    const lptr L = F.lds; const int w = F.wave;
    const unsigned char* q8 = F.ws + WS_Q; const unsigned char* kv8 = F.ws + WS_KV; unsigned char* o8 = F.ws + WS_O;
    constexpr int VIMG = 69632, STG = 139264;
    const lptr stg = L + STG + w * 2944;
    const int SK = 127, SQ = 121, SV = 127, SP = 119;
    u32x4 qt_[8];
#define A8_QROWS(b_, h_, qt__) do { const int l__ = lane_id_v(); \
        const unsigned char* src__ = q8 + ((size_t)(b_) * SEQ + (qt__) * 256 + 32 * w + (l__ >> 4)) * DM + (h_) * 256 + 16 * (l__ & 15); \
        _Pragma("unroll") for (int it = 0; it < 8; ++it) asm volatile("global_load_dwordx4 %0, %1, off" : "=v"(qt_[it]) : "v"(src__ + (size_t)(4 * it) * DM) : "memory"); } while (0)
    for (int p = F.vcu; p < 256; p += F.G) {
        const int bh = p >> 1, b = bh >> 2, h = bh & 3, qt0 = 4 * (p & 1);
        __syncthreads();
        A8_QROWS(b, h, qt0);
        attn8_img_dma<true>(L, kv8 + ((size_t)bh << 16), w);
        attn8_img_dma<false>(L + VIMG, kv8 + ((size_t)(NB * 4 + bh) << 16), w);
        __builtin_amdgcn_s_waitcnt(0);
        __builtin_amdgcn_s_barrier(); asm volatile("" ::: "memory");
#pragma unroll 1
        for (int ui = 0; ui < 4; ++ui) {
            const int ln_ = lane_id_v();
            const int lr = ln_ & 31, lh = ln_ >> 5, c16 = ln_ & 15, rs = ln_ >> 4;
            const size_t row0 = (size_t)b * SEQ + (qt0 + ui) * 256 + 32 * w;
            if (ui > 0) asm volatile("s_waitcnt vmcnt(8)" ::: "memory");
            u32x8 qf[4];
#pragma unroll
            for (int ks = 0; ks < 4; ++ks) {
                if ((c16 >> 2) == ks) {
#pragma unroll
                    for (int it = 0; it < 8; ++it) *(LAS u32x4*)(stg + (4 * it + rs) * 80 + 16 * (c16 & 3)) = qt_[it];
                }
                asm volatile("" ::: "memory");
                qf[ks] = lds32(stg + lr * 80 + 32 * lh);
                asm volatile("" ::: "memory");
            }
            asm volatile("s_waitcnt lgkmcnt(0)" ::: "memory");
            { const int un = ui + 1 < 4 ? ui + 1 : ui; A8_QROWS(b, h, qt0 + un); }
            f32x16 S[8];
            {
                const lptr kb = L + lr * 272 + 32 * lh;
                u32x8 kfA[2], kfB[2];
#define A8_KREAD(d_, i_) do { d_[0] = lds32(kb + ((i_) >> 1) * 32 * 272 + 128 * ((i_) & 1)); d_[1] = lds32(kb + ((i_) >> 1) * 32 * 272 + 128 * ((i_) & 1) + 64); } while (0)
#define A8_KMMA(s_, i_) do { if (((i_) & 1) == 0) { _Pragma("unroll") for (int i = 0; i < 16; ++i) S[(i_) >> 1][i] = 0.f; } \
        mfma8_32(S[(i_) >> 1], s_[0], qf[2 * ((i_) & 1)], SK, SQ); mfma8_32(S[(i_) >> 1], s_[1], qf[2 * ((i_) & 1) + 1], SK, SQ); } while (0)
                A8_KREAD(kfA, 0);
#pragma unroll
                for (int i2 = 0; i2 < 16; i2 += 2) {
                    A8_KREAD(kfB, i2 + 1); SCHED_FENCE(); A8_KMMA(kfA, i2); SCHED_FENCE();
                    if (i2 + 2 < 16) A8_KREAD(kfA, i2 + 2);
                    SCHED_FENCE(); A8_KMMA(kfB, i2 + 1); SCHED_FENCE();
                }
#undef A8_KREAD
#undef A8_KMMA
            }
            asm volatile("s_nop 15\n\ts_nop 15\n\ts_nop 15" : "+v"(S[0]), "+v"(S[1]), "+v"(S[2]), "+v"(S[3]), "+v"(S[4]), "+v"(S[5]), "+v"(S[6]), "+v"(S[7]));
            u32x8 pf[4]; float inv;
            {
                float mx = -INFINITY;
#pragma unroll
                for (int blk = 0; blk < 8; ++blk)
#pragma unroll
                    for (int i = 0; i < 16; i += 2) mx = fmaxf(mx, fmaxf(S[blk][i], S[blk][i + 1]));
                { auto rr = __builtin_amdgcn_permlane32_swap(__float_as_uint(mx), __float_as_uint(mx), false, false); mx = fmaxf(__uint_as_float(rr[0]), __uint_as_float(rr[1])); }
                float sum = 0.f; const float mx8 = mx - 8.f;
#pragma unroll
                for (int blk = 0; blk < 8; ++blk)
#pragma unroll
                    for (int g = 0; g < 4; ++g) { const float p0 = __builtin_amdgcn_exp2f(S[blk][4 * g] - mx8), p1 = __builtin_amdgcn_exp2f(S[blk][4 * g + 1] - mx8), p2 = __builtin_amdgcn_exp2f(S[blk][4 * g + 2] - mx8), p3 = __builtin_amdgcn_exp2f(S[blk][4 * g + 3] - mx8);
                        sum += (p0 + p1) + (p2 + p3);
                        int w_ = 0; w_ = __builtin_amdgcn_cvt_pk_fp8_f32(p0, p1, w_, false); w_ = __builtin_amdgcn_cvt_pk_fp8_f32(p2, p3, w_, true);
                        pf[blk >> 1][4 * (blk & 1) + g] = (unsigned)w_; }
                { auto rr = __builtin_amdgcn_permlane32_swap(__float_as_uint(sum), __float_as_uint(sum), false, false); sum = __uint_as_float(rr[0]) + __uint_as_float(rr[1]); }
                inv = 256.f * __builtin_amdgcn_rcpf(sum);
            }
            f32x16 O[8];
#pragma unroll
            for (int eb = 0; eb < 8; ++eb)
#pragma unroll
                for (int i = 0; i < 16; ++i) O[eb][i] = 0.f;
            {
                const lptr vb = L + VIMG + lr * 272 + 32 * lh;
                u32x8 vfA[2], vfB[2];
#define A8_VREAD(d_, i_) do { d_[0] = lds32(vb + (2 * ((i_) & 3)) * 32 * 272 + 64 * ((i_) >> 2)); d_[1] = lds32(vb + (2 * ((i_) & 3) + 1) * 32 * 272 + 64 * ((i_) >> 2)); } while (0)
#define A8_VMMA(s_, i_) do { mfma8_32(O[2 * ((i_) & 3)], s_[0], pf[(i_) >> 2], SV, SP); mfma8_32(O[2 * ((i_) & 3) + 1], s_[1], pf[(i_) >> 2], SV, SP); } while (0)
                A8_VREAD(vfA, 0);
#pragma unroll
                for (int i2 = 0; i2 < 16; i2 += 2) {
                    A8_VREAD(vfB, i2 + 1); SCHED_FENCE(); A8_VMMA(vfA, i2); SCHED_FENCE();
                    if (i2 + 2 < 16) A8_VREAD(vfA, i2 + 2);
                    SCHED_FENCE(); A8_VMMA(vfB, i2 + 1); SCHED_FENCE();
                }
#undef A8_VREAD
#undef A8_VMMA
            }
            asm volatile("s_nop 15\n\ts_nop 15\n\ts_nop 15" : "+v"(O[0]), "+v"(O[1]), "+v"(O[2]), "+v"(O[3]), "+v"(O[4]), "+v"(O[5]), "+v"(O[6]), "+v"(O[7]));
            {
                const float sc16 = inv * 16.f; u32x4 ot[8];
#pragma unroll
                for (int it = 0; it < 8; ++it) ot[it] = (u32x4){0u, 0u, 0u, 0u};
#pragma unroll
                for (int ps = 0; ps < 4; ++ps) {
#pragma unroll
                    for (int e2 = 0; e2 < 2; ++e2)
#pragma unroll
                        for (int g = 0; g < 4; ++g) { const f32x16& o = O[2 * ps + e2];
                            *(LAS unsigned*)(stg + lr * 80 + 32 * e2 + 8 * g + 4 * lh) = pk4_fp8(o[4 * g] * sc16, o[4 * g + 1] * sc16, o[4 * g + 2] * sc16, o[4 * g + 3] * sc16); }
                    asm volatile("" ::: "memory");
                    if ((c16 >> 2) == ps) {
#pragma unroll
                        for (int it = 0; it < 8; ++it) ot[it] = *(const LAS u32x4*)(stg + (4 * it + rs) * 80 + 16 * (c16 & 3));
                    }
                    asm volatile("" ::: "memory");
                }
#pragma unroll
                for (int it = 0; it < 8; ++it) *(u32x4*)(o8 + (row0 + 4 * it + rs) * DM + h * 256 + 16 * c16) = ot[it];
            }
        }
    }
    asm volatile("s_waitcnt vmcnt(0)" ::: "memory");
    __syncthreads();
#undef A8_QROWS
}

DI void p7_router(Frame& F, const Args& a) {
    const lptr L = F.lds; const int w = F.wave;
    constexpr int RW_STRIDE = 2064, RW_HALF = 37 * RW_STRIDE, RW_HIST = 2 * RW_HALF;
    LAS unsigned* hist = (LAS unsigned*)(L + RW_HIST); LAS unsigned* base = hist + 32;
    const bf16_t* x2 = (const bf16_t*)(F.ws + WS_X2B); const bf16_t* whi = (const bf16_t*)(F.ws + WS_WR); const bf16_t* wlo = whi + 48 * 1024;
    {
        const int t0 = F.wave * 64 + lane_id_v();
        u32x4 vh[10], vl[10];
#pragma unroll
        for (int j = 0; j < 10; ++j) { const int i = t0 + j * NTHR, r = (i >> 7) < 36 ? (i >> 7) : 36, c = i & 127; const int srow = r < 32 ? r : (r < 36 ? 32 + 4 * (r - 32) : 0);
            vh[j] = *(const u32x4*)(whi + (size_t)srow * 1024 + c * 8); vl[j] = *(const u32x4*)(wlo + (size_t)srow * 1024 + c * 8); }
#pragma unroll
        for (int j = 0; j < 10; ++j) { const int i = t0 + j * NTHR, r = i >> 7, c = i & 127;
            if (r < 37) { const bool z = (r == 36); *(LAS u32x4*)(L + r * RW_STRIDE + c * 16) = z ? (u32x4){0u, 0u, 0u, 0u} : vh[j]; *(LAS u32x4*)(L + RW_HALF + r * RW_STRIDE + c * 16) = z ? (u32x4){0u, 0u, 0u, 0u} : vl[j]; } }
        __syncthreads();
    }
    unsigned* gcnt = (unsigned*)(F.ws + WS_CTL) + CW_CNT;
    int* rowid = (int*)(F.ws + WS_ROWID); f32x2* rowf = (f32x2*)(F.ws + WS_ROWF);
    const float* b_group = a.in[17]; const float* b_router = a.in[19];
    for (int blk = F.vcu; blk < NT / 256; blk += F.G) {
        int tid = F.wave * 64 + lane_id(); asm volatile("" : "+v"(tid));
        const int lane = tid & 63, fr = lane & 15, fq = lane >> 4;
        if (tid < 32) hist[tid] = 0u;
        __syncthreads();
        const size_t tok0 = (size_t)blk * 256 + 32 * w;
        f32x4 acc[2][3]; float ssq[2] = {0.f, 0.f};
#pragma unroll
        for (int rg = 0; rg < 2; ++rg)
#pragma unroll
            for (int cb = 0; cb < 3; ++cb) acc[rg][cb] = (f32x4){0.f, 0.f, 0.f, 0.f};
        u32x4 xA[4][2], xB[4][2];
#define P7_LOAD(S, g_) do { _Pragma("unroll") for (int k = 0; k < 4; ++k) _Pragma("unroll") for (int rg = 0; rg < 2; ++rg) \
            asm volatile("global_load_dwordx4 %0, %1, off" : "=v"(x##S[k][rg]) : "v"(x2 + (tok0 + 16 * rg + fr) * DM + 32 * (4 * (g_) + k) + 8 * fq) : "memory"); } while (0)
#define P7_WAIT(n_, S) asm volatile("s_waitcnt vmcnt(" #n_ ")" : "+v"(x##S[0][0]), "+v"(x##S[0][1]), "+v"(x##S[1][0]), "+v"(x##S[1][1]), "+v"(x##S[2][0]), "+v"(x##S[2][1]), "+v"(x##S[3][0]), "+v"(x##S[3][1]) :: "memory")
#define P7_COMP(S, g_) do { _Pragma("unroll") for (int k = 0; k < 4; ++k) { const int ks = 4 * (g_) + k; bf16x8 xf[2]; \
            _Pragma("unroll") for (int rg = 0; rg < 2; ++rg) { const u32x4 xu = x##S[k][rg]; xf[rg] = __builtin_bit_cast(bf16x8, xu); \
                const float e0 = bflo(xu.x), e1 = bfhi(xu.x), e2 = bflo(xu.y), e3 = bfhi(xu.y), e4 = bflo(xu.z), e5 = bfhi(xu.z), e6 = bflo(xu.w), e7 = bfhi(xu.w); \
                ssq[rg] += (e0 * e0 + e1 * e1) + (e2 * e2 + e3 * e3) + (e4 * e4 + e5 * e5) + (e6 * e6 + e7 * e7); } \
            _Pragma("unroll") for (int cb = 0; cb < 3; ++cb) { const int lrow = cb < 2 ? 16 * cb + fr : ((fr & 3) == 0 ? 32 + (fr >> 2) : 36); const lptr wp = L + lrow * RW_STRIDE + (32 * ks + 8 * fq) * 2; const bf16x8 wh = lds16(wp), wl = lds16(wp + RW_HALF); \
                _Pragma("unroll") for (int rg = 0; rg < 2; ++rg) { acc[rg][cb] = mfma16(wh, xf[rg], acc[rg][cb]); acc[rg][cb] = mfma16(wl, xf[rg], acc[rg][cb]); } } } } while (0)
        P7_LOAD(A, 0); P7_LOAD(B, 1);
        P7_WAIT(8, A); P7_COMP(A, 0); P7_LOAD(A, 2); P7_WAIT(8, B); P7_COMP(B, 1); P7_LOAD(B, 3);
        P7_WAIT(8, A); P7_COMP(A, 2); P7_LOAD(A, 4); P7_WAIT(8, B); P7_COMP(B, 3); P7_LOAD(B, 5);
        P7_WAIT(8, A); P7_COMP(A, 4); P7_LOAD(A, 6); P7_WAIT(8, B); P7_COMP(B, 5); P7_LOAD(B, 7);
        P7_WAIT(8, A); P7_COMP(A, 6); P7_WAIT(0, B); P7_COMP(B, 7);
#undef P7_LOAD
#undef P7_WAIT
#undef P7_COMP
        int e1_[2], e2_[2]; unsigned r1_[2], r2_[2]; float w1_[2], w2_[2], rs_[2]; bool win_[2];
#pragma unroll
        for (int rg = 0; rg < 2; ++rg) {
            float sq = ssq[rg]; sq += __shfl_xor(sq, 16); sq += __shfl_xor(sq, 32);
            const float rstd = rsqrtf(sq * (1.f / DM) + EPS);
            float l[8];
#pragma unroll
            for (int i = 0; i < 4; ++i) { l[i] = acc[rg][0][i] * rstd + b_router[8 * fq + i]; l[4 + i] = acc[rg][1][i] * rstd + b_router[8 * fq + 4 + i]; }
            const float gl = acc[rg][2][0] * rstd + b_group[fq];
            const float g0 = __shfl(gl, fr), g1 = __shfl(gl, fr + 16), g2 = __shfl(gl, fr + 32), g3 = __shfl(gl, fr + 48);
            int gsel = 0; float gmax = g0;
            if (g1 > gmax) { gmax = g1; gsel = 1; } if (g2 > gmax) { gmax = g2; gsel = 2; } if (g3 > gmax) { gmax = g3; gsel = 3; }
            const float gw = 1.f / (__expf(g0 - gmax) + __expf(g1 - gmax) + __expf(g2 - gmax) + __expf(g3 - gmax));
            int i1 = 0; float m1 = l[0];
#pragma unroll
            for (int i = 1; i < 8; ++i) if (l[i] > m1) { m1 = l[i]; i1 = i; }
            int i2 = -1; float m2 = -INFINITY;
#pragma unroll
            for (int i = 0; i < 8; ++i) if (i != i1 && l[i] > m2) { m2 = l[i]; i2 = i; }
            const float p2 = __expf(m2 - m1);
            win_[rg] = (fq == gsel); e1_[rg] = 8 * fq + i1; e2_[rg] = 8 * fq + i2; w1_[rg] = gw / (1.f + p2); w2_[rg] = gw * p2 / (1.f + p2); rs_[rg] = rstd;
            r1_[rg] = 0u; r2_[rg] = 0u;
            if (win_[rg]) { r1_[rg] = atomicAdd((unsigned*)&hist[e1_[rg]], 1u); r2_[rg] = atomicAdd((unsigned*)&hist[e2_[rg]], 1u); }
        }
        __syncthreads();
        if (tid < 32) base[tid] = atomicAdd(&gcnt[tid], hist[tid]);
        __syncthreads();
#pragma unroll
        for (int rg = 0; rg < 2; ++rg) if (win_[rg]) {
            const int tok = (int)tok0 + 16 * rg + fr;
            const size_t s1 = (size_t)e1_[rg] * CAPE + base[e1_[rg]] + r1_[rg], s2 = (size_t)e2_[rg] * CAPE + base[e2_[rg]] + r2_[rg];
            rowid[s1] = 2 * tok; rowf[s1] = (f32x2){rs_[rg], w1_[rg]}; rowid[s2] = 2 * tok + 1; rowf[s2] = (f32x2){rs_[rg], w2_[rg]};
        }
        __syncthreads();
    }
}
DI void moe_setup(Frame& F) {
    LAS int* tb = (LAS int*)(F.lds + MISC_OFF); LAS int* cn = tb + 40;
    const unsigned* gcnt = (const unsigned*)(F.ws + WS_CTL) + CW_CNT;
    const int tid = F.wave * 64 + lane_id();
    __syncthreads();
    if (tid < 32) cn[tid] = (int)__hip_atomic_load(gcnt + tid, __ATOMIC_RELAXED, __HIP_MEMORY_SCOPE_AGENT);
    __syncthreads();
    if (tid == 0) { int acc = 0; for (int e = 0; e < 32; ++e) { tb[e] = acc; acc += (cn[e] + 255) >> 8; } tb[32] = acc; }
    __syncthreads();
}
struct SchedMoE {
    LAS const int* tb; LAS const int* cn; int G, vcu, K, gather; const char* A; const char* Bbase; size_t b_estride, b_tstride; const int* rowid;
    DI bool next(int i, pg8::Unit& u) const {
        const int L = i * G + vcu; if (L >= tb[32] * 4) return false;
        const int t = L >> 2, pn = L & 3; int e = 0;
#pragma unroll
        for (int j = 1; j < 32; ++j) e += (tb[j] <= t) ? 1 : 0;
        u.pm = t; u.pn = pn; u.tag = e; u.aux = t - tb[e];
        u.B = Bbase + (size_t)e * b_estride + (size_t)pn * b_tstride;
        u.A = gather ? A : A + (size_t)t * 256 * K;
        return true;
    }
    DI unsigned arow(const pg8::Unit& u, int row) const { const int slot = u.aux * 256 + row; return slot < cn[u.tag] ? (unsigned)(rowid[(size_t)u.tag * CAPE + slot] >> 1) : 0u; }
    DI const int* arow_ptr(const pg8::Unit& u, int row) const { return rowid + ((size_t)u.tag * CAPE + u.aux * 256 + row); }
    DI int rows_left(const pg8::Unit& u) const { return cn[u.tag] - u.aux * 256; }
};
struct EpiM1 {
    const f32x2* rowf; bf16_t* hid;
    static constexpr int NPRE = 8;
    DI void prefetch(unsigned (&pre)[8], const pg8::Unit& u, int wr, int fr) const {
        asm volatile("" : "+v"(fr));
#pragma unroll
        for (int ai = 0; ai < 2; ++ai)
#pragma unroll
            for (int m = 0; m < 4; ++m) asm volatile("global_load_dword %0, %1, off" : "=v"(pre[ai * 4 + m]) : "v"((const float*)(rowf + ((size_t)u.tag * CAPE + u.aux * 256 + ai * 128 + wr * 64 + m * 16 + fr))) : "memory");
    }
    DI void operator()(const f32x4 (&acc)[2][2][4][2], const pg8::Unit& u, int wr, int wc, int fr, int fq, const unsigned (&pre)[8]) const {
        asm volatile("" : "+v"(fr), "+v"(fq));
        float rs[2][4];
#pragma unroll
        for (int ai = 0; ai < 2; ++ai)
#pragma unroll
            for (int m = 0; m < 4; ++m) rs[ai][m] = __uint_as_float(pre[ai * 4 + m]);
#pragma unroll
        for (int ai = 0; ai < 2; ++ai)
#pragma unroll
            for (int m = 0; m < 4; ++m) {
                const int row = ai * 128 + wr * 64 + m * 16 + fr; const float rstd = rs[ai][m];
                const f32x4 g0 = acc[ai][0][m][0] * rstd, g1 = acc[ai][0][m][1] * rstd, u0 = acc[ai][1][m][0] * rstd, u1 = acc[ai][1][m][1] * rstd;
                u32x2 w; w.x = pk4_fp8(silu_f(g0[0]) * u0[0], silu_f(g0[1]) * u0[1], silu_f(g0[2]) * u0[2], silu_f(g0[3]) * u0[3]);
                w.y = pk4_fp8(silu_f(g1[0]) * u1[0], silu_f(g1[1]) * u1[1], silu_f(g1[2]) * u1[2], silu_f(g1[3]) * u1[3]);
                *(u32x2*)((unsigned char*)hid + ((size_t)u.pm * 256 + row) * DEXP + u.pn * 128 + wc * 32 + 8 * fq) = w;
            }
    }
};
struct EpiM2 {
    LAS const int* cn; const int* rowid; const f32x2* rowf; bf16_t* ybuf;
    static constexpr int NPRE = 16;
    DI void prefetch(unsigned (&pre)[16], const pg8::Unit& u, int wr, int fr) const {
        asm volatile("" : "+v"(fr));
#pragma unroll
        for (int ai = 0; ai < 2; ++ai)
#pragma unroll
            for (int m = 0; m < 4; ++m) { const size_t si = (size_t)u.tag * CAPE + u.aux * 256 + ai * 128 + wr * 64 + m * 16 + fr;
                asm volatile("global_load_dword %0, %1, off" : "=v"(pre[ai * 4 + m]) : "v"(rowid + si) : "memory");
                asm volatile("global_load_dword %0, %1, off" : "=v"(pre[8 + ai * 4 + m]) : "v"((const float*)(rowf + si) + 1) : "memory"); }
    }
    DI void operator()(const f32x4 (&acc)[2][2][4][2], const pg8::Unit& u, int wr, int wc, int fr, int fq, const unsigned (&pre)[16]) const {
        asm volatile("" : "+v"(fr), "+v"(fq));
        int ids[2][4]; float wgs[2][4];
#pragma unroll
        for (int ai = 0; ai < 2; ++ai)
#pragma unroll
            for (int m = 0; m < 4; ++m) { ids[ai][m] = (int)pre[ai * 4 + m]; wgs[ai][m] = __uint_as_float(pre[8 + ai * 4 + m]); }
        const int cnt = cn[u.tag];
#pragma unroll
        for (int ai = 0; ai < 2; ++ai)
#pragma unroll
            for (int m = 0; m < 4; ++m) {
                const int row = ai * 128 + wr * 64 + m * 16 + fr, slot = u.aux * 256 + row;
                if (slot < cnt) {
                    const int id = ids[ai][m]; const float wg = wgs[ai][m];
#pragma unroll
                    for (int bj = 0; bj < 2; ++bj) { const f32x4 v0 = acc[ai][bj][m][0] * (wg * 16.f), v1 = acc[ai][bj][m][1] * (wg * 16.f);
                        u32x2 w; w.x = pk4_fp8(v0[0], v0[1], v0[2], v0[3]); w.y = pk4_fp8(v1[0], v1[1], v1[2], v1[3]);
                        *(u32x2*)((unsigned char*)ybuf + (size_t)id * DM + u.pn * 256 + bj * 128 + wc * 32 + 8 * fq) = w; }
                }
            }
    }
};

DI void p_final(Frame& F, const Args& a, size_t src_off) {
    const int gw = F.vcu * NWAVES + F.wave, NGW = F.G * NWAVES, lane = lane_id_v();
    const bf16_t* x2 = (const bf16_t*)(F.ws + src_off); const unsigned char* yb = F.ws + WS_YBUF;
    const float* g = a.in[23];
    f32x4 gv[4];
#pragma unroll
    for (int j = 0; j < 4; ++j) gv[j] = *((const f32x4*)g + lane * 2 + (j & 1) + 128 * (j >> 1));
    u32x4 xaA[2], xaB[2], xaC[2]; u32x2 y0A[2], y0B[2], y0C[2], y1A[2], y1B[2], y1C[2];
#define PF_LOAD(S, row_) do { const int r_ = (row_) < NT ? (row_) : gw; _Pragma("unroll") for (int hlf = 0; hlf < 2; ++hlf) { \
        asm volatile("global_load_dwordx4 %0, %1, off" : "=v"(xa##S[hlf]) : "v"((const u32x4*)(x2 + (size_t)r_ * DM) + lane + 64 * hlf) : "memory"); \
        asm volatile("global_load_dwordx2 %0, %1, off" : "=v"(y0##S[hlf]) : "v"((const u32x2*)(yb + (size_t)(2 * r_) * DM) + lane + 64 * hlf) : "memory"); \
        asm volatile("global_load_dwordx2 %0, %1, off" : "=v"(y1##S[hlf]) : "v"((const u32x2*)(yb + (size_t)(2 * r_ + 1) * DM) + lane + 64 * hlf) : "memory"); } } while (0)
#define PF_WAIT(n_, S) asm volatile("s_waitcnt vmcnt(" #n_ ")" : "+v"(xa##S[0]), "+v"(xa##S[1]), "+v"(y0##S[0]), "+v"(y0##S[1]), "+v"(y1##S[0]), "+v"(y1##S[1]) :: "memory")
#define PF_Y8(q, W, HI) { const f32x2 f0 = __builtin_amdgcn_cvt_pk_f32_fp8((int)a0.W, HI), f1 = __builtin_amdgcn_cvt_pk_f32_fp8((int)a1.W, HI); \
        t[2 * q] += (f0[0] + f1[0]) * 0.0625f; t[2 * q + 1] += (f0[1] + f1[1]) * 0.0625f; }
#define PF_DO(S, row_) do { const int ro_ = (row_) < NT ? (row_) : gw; float v[16]; \
        _Pragma("unroll") for (int hlf = 0; hlf < 2; ++hlf) { const u32x4 xv = xa##S[hlf]; \
            float t[8] = {bflo(xv.x), bfhi(xv.x), bflo(xv.y), bfhi(xv.y), bflo(xv.z), bfhi(xv.z), bflo(xv.w), bfhi(xv.w)}; \
            { const u32x2 a0 = y0##S[hlf], a1 = y1##S[hlf]; PF_Y8(0, x, false) PF_Y8(1, x, true) PF_Y8(2, y, false) PF_Y8(3, y, true) } \
            _Pragma("unroll") for (int j = 0; j < 8; ++j) v[8 * hlf + j] = t[j]; } \
        float s = 0.f; _Pragma("unroll") for (int j = 0; j < 16; ++j) s += v[j] * v[j]; \
        const float rstd = rsqrtf(wave_sum(s) * (1.f / DM) + EPS); \
        f32x4* o = (f32x4*)(a.out + (size_t)ro_ * DM); \
        _Pragma("unroll") for (int j = 0; j < 4; ++j) { f32x4 r; r.x = v[4 * j] * rstd * gv[j].x; r.y = v[4 * j + 1] * rstd * gv[j].y; r.z = v[4 * j + 2] * rstd * gv[j].z; r.w = v[4 * j + 3] * rstd * gv[j].w; \
            o[lane * 2 + (j & 1) + 128 * (j >> 1)] = r; } } while (0)
    PF_LOAD(A, gw); PF_LOAD(B, gw + NGW); PF_LOAD(C, gw + 2 * NGW);
    PF_WAIT(12, A); PF_DO(A, gw); PF_LOAD(A, gw + 3 * NGW);
    PF_WAIT(16, B); PF_DO(B, gw + NGW); PF_LOAD(B, gw + 4 * NGW);
    for (int m = gw + 2 * NGW; m < NT; m += 3 * NGW) {
        PF_WAIT(20, C); PF_DO(C, m); PF_LOAD(C, m + 3 * NGW);
        PF_WAIT(20, A); PF_DO(A, m + NGW); PF_LOAD(A, m + 4 * NGW);
        PF_WAIT(20, B); PF_DO(B, m + 2 * NGW); PF_LOAD(B, m + 5 * NGW);
    }
#undef PF_LOAD
#undef PF_WAIT
#undef PF_Y8
#undef PF_DO
}

__global__ void __launch_bounds__(NTHR, 2) fwd_megakernel(Args args) {
    extern __shared__ __attribute__((aligned(16))) unsigned char lds_raw[];
    Frame F;
    F.lds = (lptr)lds_raw; F.wave = __builtin_amdgcn_readfirstlane((int)threadIdx.x >> 6);
    F.G = gridDim.x; F.bx = blockIdx.x; F.vcu = (F.G % 8 == 0) ? (F.bx % 8) * (F.G / 8) + F.bx / 8 : F.bx;
    F.ws = args.ws;
    const int lo = args.ph_lo, hi = args.ph_hi;
    const bool leader = (F.wave == 0) && (lane_id() == 0);
    { volatile LAS unsigned* st = (volatile LAS unsigned*)(F.lds + MISC_OFF + 768); if (leader) { st[0] = 0u; st[1] = 0u; } }
    __syncthreads();
    const XcdBarrier gbar = xcd_barrier_post((unsigned*)(F.ws + WS_CTL) + CW_BAR, (volatile LAS unsigned*)(F.lds + MISC_OFF + 768), leader);
#define IN(k) (lo <= (k) && (k) < hi)
#define SEAM(k) do { if (IN(k) && hi > (k) + 1) xcd_barrier(gbar, (F.wave == 0) && (lane_id() == 0)); } while (0)
    if (IN(0)) { p0_prologue(F, args); __syncthreads(); moe_weight_items(F, args, F.vcu * NWAVES + F.wave, F.G * NWAVES, MW_SPLIT, 3 * 32 * 16 * 16); }
    SEAM(0);
    if (IN(1)) {
        SchedDense S; S.o.init(NT, NP1, F.G, F.bx); S.A = (const char*)(F.ws + WS_XN0); S.B = (const char*)(F.ws + WS_WIN); S.K = DM;
        EpiP1 E{(bf16_t*)(F.ws + WS_PROJ), (bf16_t*)(F.ws + WS_KV), (const f32x4*)(F.ws + WS_ROPE)};
        pg8::gemm_phase<EpiP1, SchedDense, false>(F.lds, 2 * DM, S, E, F.wave);
    }
    SEAM(1);
    if (IN(2)) { p2_mixer(F, args); }
    SEAM(2);
    if (IN(3)) {
        SchedDense S; S.o.init(NT, DM, F.G, F.bx); S.A = (const char*)(F.ws + WS_MIX); S.B = (const char*)(F.ws + WS_WOUT); S.K = DM;
        EpiP3 E{(const bf16_t*)(F.ws + WS_XN0), (const float*)(F.ws + WS_RMS), (bf16_t*)(F.ws + WS_X1B), (float*)(F.ws + WS_SSQ1), F.ws + WS_X1Q8};
        pg8::gemm_phase<EpiP3, SchedDense, false>(F.lds, 2 * DM, S, E, F.wave);
    }
    SEAM(3);
    if (IN(4)) {
        SchedDense S; S.o.init(NT, DM, F.G, F.bx); S.A = (const char*)(F.ws + WS_X1Q8); S.B = (const char*)(F.ws + WS_WQ); S.K = DM / 2;
        EpiP4 E{(const float*)(F.ws + WS_SSQ1), F.ws + WS_Q};
        pg8::gemm_phase<EpiP4, SchedDense, false, true>(F.lds, DM, S, E, F.wave, 124);
    }
    SEAM(4);
    if (IN(5)) { attn8_phase(F); }
    SEAM(5);
    if (IN(6)) {
        SchedDense S; S.o.init(NT, DM, F.G, F.bx); S.A = (const char*)(F.ws + WS_O); S.B = (const char*)(F.ws + WS_WO); S.K = DM / 2;
        EpiP6 E{(const bf16_t*)(F.ws + WS_X1B), (bf16_t*)(F.ws + WS_X2B), F.ws + WS_XQ8};
        pg8::gemm_phase<EpiP6, SchedDense, false, true>(F.lds, DM, S, E, F.wave, 122, 123);
    }
    SEAM(6);
    if (IN(7)) { p7_router(F, args); }
    SEAM(7);
    if (IN(8)) {
        moe_setup(F);
        SchedMoE S; S.tb = (LAS const int*)(F.lds + MISC_OFF); S.cn = S.tb + 40; S.G = F.G; S.vcu = F.vcu; S.K = DM; S.gather = 1;
        S.A = (const char*)(F.ws + WS_XQ8); S.Bbase = (const char*)(F.ws + WS_W1); S.b_estride = (size_t)1024 * DM; S.b_tstride = (size_t)256 * DM; S.rowid = (const int*)(F.ws + WS_ROWID);
        EpiM1 E{(const f32x2*)(F.ws + WS_ROWF), (bf16_t*)(F.ws + WS_HID)};
        pg8::gemm_phase<EpiM1, SchedMoE, true, true>(F.lds, DM, S, E, F.wave, 122);
    }
    SEAM(8);
    if (IN(9)) {
        moe_setup(F);
        SchedMoE S; S.tb = (LAS const int*)(F.lds + MISC_OFF); S.cn = S.tb + 40; S.G = F.G; S.vcu = F.vcu; S.K = DEXP; S.gather = 0;
        S.A = (const char*)(F.ws + WS_HID); S.Bbase = (const char*)(F.ws + WS_W2); S.b_estride = (size_t)DM * DEXP; S.b_tstride = (size_t)256 * DEXP; S.rowid = (const int*)(F.ws + WS_ROWID);
        EpiM2 E{S.cn, (const int*)(F.ws + WS_ROWID), (const f32x2*)(F.ws + WS_ROWF), (bf16_t*)(F.ws + WS_YBUF)};
        pg8::gemm_phase<EpiM2, SchedMoE, false, true>(F.lds, DEXP, S, E, F.wave, 123);
    }
    SEAM(9);
    if (IN(10)) { p_final(F, args, WS_X2B); }
#undef IN
#undef SEAM
}


#if DUPK == 55
__global__ void __launch_bounds__(NTHR, 2) attn_probe_kernel(Args args) {
    extern __shared__ __attribute__((aligned(16))) unsigned char lds_raw[];
    Frame F;
    F.lds = (lptr)lds_raw; F.wave = __builtin_amdgcn_readfirstlane((int)threadIdx.x >> 6);
    F.G = gridDim.x; F.bx = blockIdx.x; F.vcu = (F.G % 8 == 0) ? (F.bx % 8) * (F.G / 8) + F.bx / 8 : F.bx;
    F.ws = args.ws;
    attn_phase<DBGV>(F);
}
#endif
extern "C" void kernel_launch(void* const* d_in, const int* in_sizes, int n_in, void* d_out, int out_size, void* d_ws, size_t ws_size, hipStream_t stream) {
    static int grid = 0;
    if (grid == 0) {
        if (n_in != 24 || out_size != NT * DM || ws_size < WS_END) { fprintf(stderr, "kernel_launch: unexpected shapes (n_in %d out %d ws %zu)\n", n_in, out_size, ws_size); grid = -1; return; }
        int dev = 0, cus = 0, per_cu = 0;
        hipGetDevice(&dev); hipDeviceGetAttribute(&cus, hipDeviceAttributeMultiprocessorCount, dev);
        hipFuncSetAttribute((const void*)fwd_megakernel, hipFuncAttributeMaxDynamicSharedMemorySize, LDS_BYTES);
        hipOccupancyMaxActiveBlocksPerMultiprocessor(&per_cu, (const void*)fwd_megakernel, NTHR, LDS_BYTES);
        if (per_cu < 1) { fprintf(stderr, "kernel_launch: occupancy query says %d blocks/CU\n", per_cu); per_cu = 1; }
        (void)hipGetLastError();
        grid = cus * 1;
        if (grid > 256) grid = 256;
    }
    if (grid < 0) return;
    hipMemsetAsync((char*)d_ws + WS_CTL, 0, CTL_ZERO_BYTES, stream);
    Args a{};
    for (int i = 0; i < 24; ++i) a.in[i] = (const float*)d_in[i];
    a.out = (float*)d_out; a.ws = (unsigned char*)d_ws; a.ph_lo = 0; a.ph_hi = 11; a.dupk = DUPK; a.dbg = 0;
    void* kargs[] = {&a};
    hipError_t e = hipLaunchCooperativeKernel((const void*)fwd_megakernel, dim3(grid), dim3(NTHR), kargs, LDS_BYTES, stream);
    if (e != hipSuccess) fprintf(stderr, "cooperative launch failed: %s (grid %d)\n", hipGetErrorString(e), grid);
#if DUPK == 55
    { static bool once = false; if (!once) { hipFuncSetAttribute((const void*)attn_probe_kernel, hipFuncAttributeMaxDynamicSharedMemorySize, LDS_BYTES); once = true; }
      void* pa[] = {&a}; hipLaunchCooperativeKernel((const void*)attn_probe_kernel, dim3(grid), dim3(NTHR), pa, LDS_BYTES, stream); }
#elif DUPK >= 0
    hipMemsetAsync((char*)d_ws + WS_CTL + 4096 * 4, 0, 16384, stream);
    a.ph_lo = DUPK; a.ph_hi = DUPK + 1; a.dbg = DBGV;
    e = hipLaunchCooperativeKernel((const void*)fwd_megakernel, dim3(grid), dim3(NTHR), kargs, LDS_BYTES, stream);
#endif
}
```

```cpp
#include <hip/hip_runtime.h>
#include <hip/hip_cooperative_groups.h>
#include <cstdio>
#include <cstdint>
namespace cg = cooperative_groups;
#ifndef DUPK
#define DUPK (-1)
#endif
#ifndef DBGV
#define DBGV 0
#endif

#define DI __device__ __forceinline__
#define LAS __attribute__((address_space(3)))
typedef unsigned short bf16_t;
typedef short bf16x8 __attribute__((ext_vector_type(8)));
typedef short s16x4 __attribute__((ext_vector_type(4)));
typedef float f32x4 __attribute__((ext_vector_type(4)));
typedef float f32x2 __attribute__((ext_vector_type(2)));
typedef unsigned u32x4 __attribute__((ext_vector_type(4)));
typedef unsigned u32x2 __attribute__((ext_vector_type(2)));
typedef __bf16 bf16x2_t __attribute__((ext_vector_type(2)));
typedef LAS unsigned char* lptr;

constexpr int NT = 65536, DM = 1024, SEQ = 2048, NB = 32;
constexpr int INW = 3592, NP1 = 3584;
constexpr int MEMT = 8192;
constexpr int NEXP = 32, DEXP = 512;
constexpr int CAPE = 131072;
constexpr float EPS = 1e-6f;
constexpr int NWAVES = 8, NTHR = 512;

constexpr size_t MiB = 1u << 20;
constexpr size_t WS_CTL = 0, CTL_ZERO_BYTES = 64 * 1024;
constexpr size_t WS_WIN  = 1 * MiB;
constexpr size_t WS_WOUT = 8 * MiB;
constexpr size_t WS_WQ   = 10 * MiB;
constexpr size_t WS_WKV  = 12 * MiB;
constexpr size_t WS_WO   = 16 * MiB;
constexpr size_t WS_W1   = 18 * MiB;
constexpr size_t WS_W2   = 82 * MiB;
constexpr size_t WS_WR   = 114 * MiB;
constexpr size_t WS_ROPE = 115 * MiB;
constexpr size_t WS_GATES = 116 * MiB;
constexpr size_t WS_SSQ1 = 118 * MiB;
constexpr size_t WS_ROWID = 122 * MiB;
constexpr size_t WS_ROWF = 138 * MiB;
constexpr size_t WS_MEMN = 170 * MiB;
constexpr size_t WS_KV   = 186 * MiB;
constexpr size_t WS_A    = 218 * MiB;
constexpr size_t WS_B    = 346 * MiB;
constexpr size_t WS_C    = 794 * MiB;
constexpr size_t WS_XN0 = WS_A, WS_X1B = WS_A;
constexpr size_t WS_PROJ = WS_B, WS_Q = WS_B, WS_O = WS_B + 128 * MiB, WS_X2B = WS_B + 256 * MiB, WS_YBUF = WS_B;
constexpr size_t WS_MIX = WS_C, WS_HID = WS_C;
constexpr size_t WS_X1Q8 = WS_B + 128 * MiB;
constexpr size_t WS_XQ8 = WS_B + 384 * MiB;
constexpr size_t WS_GARR = 930 * MiB;
constexpr size_t WS_RMS = 934 * MiB;
constexpr size_t WS_END = 935 * MiB;
constexpr int CW_CNT = 64;
constexpr int CW_BAR = 4096;

constexpr int LDS_BYTES = 163840;
constexpr int MISC_OFF = 162816;

DI int lane_id() { return (int)__builtin_amdgcn_mbcnt_hi(~0u, __builtin_amdgcn_mbcnt_lo(~0u, 0u)); }
DI int lane_id_v() { int l; asm volatile("v_mbcnt_lo_u32_b32 %0, -1, 0\n\tv_mbcnt_hi_u32_b32 %0, -1, %0" : "=v"(l)); return l; }
DI float bf2f(unsigned short u) { return __uint_as_float((unsigned)u << 16); }
DI float bflo(unsigned u) { return __uint_as_float(u << 16); }
DI float bfhi(unsigned u) { return __uint_as_float(u & 0xffff0000u); }
DI unsigned pk2(float lo, float hi) { f32x2 v = {lo, hi}; bf16x2_t b = __builtin_convertvector(v, bf16x2_t); return __builtin_bit_cast(unsigned, b); }
DI float wave_sum(float v) {
#pragma unroll
    for (int o = 1; o < 64; o <<= 1) v += __shfl_xor(v, o);
    return v;
}
DI f32x4 mfma16(bf16x8 a, bf16x8 b, f32x4 c) { return __builtin_amdgcn_mfma_f32_16x16x32_bf16(a, b, c, 0, 0, 0); }
DI bf16x8 lds16(lptr p) { return *(const LAS bf16x8*)p; }
DI s16x4 ldstr(lptr p) { return __builtin_bit_cast(s16x4, __builtin_amdgcn_ds_read_tr16_b64_v4i16((LAS s16x4*)p)); }
DI bf16x8 cat4(s16x4 a, s16x4 b) { return (bf16x8){a[0], a[1], a[2], a[3], b[0], b[1], b[2], b[3]}; }
#define SCHED_FENCE() __builtin_amdgcn_sched_barrier(0)
DI u32x4 pair16(u32x2 a, u32x2 b) {
    const auto rx = __builtin_amdgcn_permlane16_swap(a.x, b.x, false, false); const auto ry = __builtin_amdgcn_permlane16_swap(a.y, b.y, false, false);
    return (u32x4){rx[0], ry[0], rx[1], ry[1]};
}
DI float clamp448(float v) { return fminf(fmaxf(v, -448.f), 448.f); }
DI unsigned pk4_fp8(float a, float b, float c, float d) {
    int w = 0; w = __builtin_amdgcn_cvt_pk_fp8_f32(clamp448(a), clamp448(b), w, false); w = __builtin_amdgcn_cvt_pk_fp8_f32(clamp448(c), clamp448(d), w, true); return (unsigned)w; }
DI float silu_f(float x) { return x * __builtin_amdgcn_rcpf(1.f + __expf(-x)); }
DI float sigm_f(float x) { return __builtin_amdgcn_rcpf(1.f + __expf(-x)); }

namespace pg8 {
constexpr int BM = 256, BK = 64, HALF = 128, HTB = HALF * BK * 2, STAGE_BYTES = 8 * HTB, NXCD = 8, WGM = 8;
__host__ __device__ __forceinline__ int lds_byte(int r, int c) { const int st = (r >> 4) * 2 + (c >> 5), rr = r & 15, cc = c & 31, ob = rr * 64 + cc * 2; return st * 1024 + (ob ^ (((ob >> 9) & 1) << 5)); }
__host__ __device__ __forceinline__ void stage_rc(int b, int& R, int& C) { const int st = b / 1024, sb = b % 1024, swz = sb ^ (((sb >> 9) & 1) << 5); R = (st >> 1) * 16 + swz / 64; C = (st & 1) * 32 + (swz % 64) / 2; }
__host__ __device__ __forceinline__ int perm32(int rho) { const int n = rho >> 4, i = rho & 15; return 8 * (i >> 2) + 4 * n + (i & 3); }

struct Unit { const char* A; const char* B; int pm, pn, tag, aux; };

struct DenseOrder {
    int nM, nN, nwg, G, c;
    DI void init(int M, int N, int G_, int c_) { nM = M / BM; nN = N / BM; nwg = nM * nN; G = G_; c = c_; }
    DI bool tile(int i, int& pm, int& pn) const {
        const long L = (long)i * G + c; if (L >= nwg) return false;
        int wgid = (int)L; { const int q = nwg / NXCD, r = nwg % NXCD, xcd = wgid % NXCD, off = wgid / NXCD; wgid = (xcd < r ? xcd * (q + 1) : r * (q + 1) + (xcd - r) * q) + off; }
        const int nig = WGM * nN, gid = wgid / nig, fm = gid * WGM, gsz = (nM - fm) < WGM ? (nM - fm) : WGM;
        pm = fm + ((wgid % nig) % gsz); pn = (wgid % nig) / gsz; return true;
    }
};

typedef int v8i32 __attribute__((ext_vector_type(8)));
template <class Epi, class Sched, bool GATHER, bool FP8 = false>
DI void gemm_phase(lptr lds, const int pitch  , const Sched& S, const Epi& E, const int wid, const int scale_w = 127, const int scale_x = 127) {
    const int K = pitch >> 1;
    const int lane = lane_id(), tid = wid * 64 + lane, wr = wid >> 2, wc = wid & 3, fr = lane & 15, fq = lane >> 4;
    const int nt = pitch / (BK * 2);
    unsigned vA[2][2], nvA[2][2], voffB[2];
#pragma unroll
    for (int i = 0; i < 2; ++i) { int R, C; stage_rc(tid * 16 + i * 8192, R, C); const int Rb = (R & ~31) + perm32(R & 31);
        vA[0][i] = (unsigned)(R * K + C) * 2u; vA[1][i] = (unsigned)((R + HALF) * K + C) * 2u; voffB[i] = (unsigned)(Rb * K + C) * 2u;
        nvA[0][i] = vA[0][i]; nvA[1][i] = vA[1][i]; }
    const size_t kstep = (size_t)(BK * 2);
    const size_t hstep = (size_t)HALF * K * 2;
    const unsigned ldsw = (unsigned)wid * 1024u;
    const int aoff = FP8 ? lds_byte(wr * 64 + fr, fq * 16) : lds_byte(wr * 64 + fr, fq * 8), boff = FP8 ? lds_byte(wc * 32 + fr, fq * 16) : lds_byte(wc * 32 + fr, fq * 8);
#define PG8_SA(b, h) (((b) * 2 + (h)) * HTB)
#define PG8_SB(b, h) ((4 + (b) * 2 + (h)) * HTB)
#define PG8_STAGE(bufoff, gbase, voff) do { _Pragma("unroll") for (int _i = 0; _i < 2; ++_i) \
        __builtin_amdgcn_global_load_lds((const unsigned*)((const char*)(gbase) + (voff)[_i]), (LAS unsigned*)(lds + (bufoff) + ldsw + _i * 8192), 16, 0, 0); } while (0)
#define PG8_LD8(p_) __builtin_shufflevector(*(const LAS u32x4*)(p_), *(const LAS u32x4*)((p_) + 16), 0, 1, 2, 3, 4, 5, 6, 7)
#define PG8_LDA(dst, b, h) do { if constexpr (FP8) { _Pragma("unroll") for (int m = 0; m < 4; ++m) dst##8[m] = PG8_LD8(lds + PG8_SA(b, h) + aoff + m * 2048); } \
        else { _Pragma("unroll") for (int m = 0; m < 4; ++m) _Pragma("unroll") for (int k = 0; k < 2; ++k) dst[m][k] = *(const LAS bf16x8*)(lds + PG8_SA(b, h) + aoff + m * 2048 + k * 1024); } } while (0)
#define PG8_LDB(dst, b, h) do { if constexpr (FP8) { _Pragma("unroll") for (int n = 0; n < 2; ++n) dst##8[n] = PG8_LD8(lds + PG8_SB(b, h) + boff + n * 2048); } \
        else { _Pragma("unroll") for (int n = 0; n < 2; ++n) _Pragma("unroll") for (int k = 0; k < 2; ++k) dst[n][k] = *(const LAS bf16x8*)(lds + PG8_SB(b, h) + boff + n * 2048 + k * 1024); } } while (0)
#define PG8_MMA(ai, bj, At, Bt) do { __builtin_amdgcn_s_setprio(1); _Pragma("unroll") for (int m = 0; m < 4; ++m) _Pragma("unroll") for (int n = 0; n < 2; ++n) { \
        if constexpr (FP8) asm volatile("v_mfma_scale_f32_16x16x128_f8f6f4 %0, %1, %2, %0, %3, %4 op_sel_hi:[0,0,0]" : "+v"(acc[ai][bj][m][n]) : "v"(Bt##8[n]), "v"(At##8[m]), "v"(scw_), "v"(sca_));   \
        else { _Pragma("unroll") for (int k = 0; k < 2; ++k) acc[ai][bj][m][n] = __builtin_amdgcn_mfma_f32_16x16x32_bf16(Bt[n][k], At[m][k], acc[ai][bj][m][n], 0, 0, 0); } } \
        __builtin_amdgcn_s_setprio(0); } while (0)
#define PG8_WAIT_V(n) asm volatile("s_waitcnt vmcnt(" #n ")" ::: "memory")
#define PG8_WAIT_L(n) asm volatile("s_waitcnt lgkmcnt(" #n ")" ::: "memory")
#define PG8_BAR __builtin_amdgcn_s_barrier()
#define PG8_SCHED __builtin_amdgcn_sched_barrier(0)
    Unit cur, nxt; int ui = 0;
    if (!S.next(0, cur)) return;
    if constexpr (GATHER) {
        int t2 = tid; asm volatile("" : "+v"(t2));
#pragma unroll
        for (int i = 0; i < 2; ++i) { int R, C; stage_rc(t2 * 16 + i * 8192, R, C);
#pragma unroll
            for (int h = 0; h < 2; ++h) vA[h][i] = S.arow(cur, h * HALF + R) * (unsigned)(K * 2) + (unsigned)C * 2u; }
    }
    f32x4 acc[2][2][4][2];
#pragma unroll
    for (int a = 0; a < 2; ++a)
#pragma unroll
        for (int b = 0; b < 2; ++b)
#pragma unroll
            for (int m = 0; m < 4; ++m)
#pragma unroll
                for (int n = 0; n < 2; ++n) acc[a][b][m][n] = (f32x4){0.f, 0.f, 0.f, 0.f};
    bf16x8 At[4][2], B0[2][2], B1[2][2];
    typedef unsigned u32x8 __attribute__((ext_vector_type(8)));
    u32x8 At8[4], B08[2], B18[2];
    const int scw_ = scale_w, sca_ = scale_x;
    const char* cA = cur.A; const char* cB = cur.B;
    PG8_STAGE(PG8_SB(0, 0), cB, voffB); PG8_STAGE(PG8_SB(0, 1), cB + hstep, voffB); PG8_STAGE(PG8_SA(0, 0), cA, vA[0]); PG8_STAGE(PG8_SA(0, 1), cA, vA[1]);
    if (wr == 1) PG8_BAR;
    PG8_WAIT_V(2); PG8_BAR;
    PG8_STAGE(PG8_SB(1, 0), cB + kstep, voffB); PG8_STAGE(PG8_SA(1, 0), cA + kstep, vA[0]); PG8_STAGE(PG8_SB(1, 1), cB + hstep + kstep, voffB);
    PG8_WAIT_V(6); PG8_BAR;
    unsigned pre[Epi::NPRE > 0 ? Epi::NPRE : 1];
    for (;;) {
        const bool has_next = S.next(ui + 1, nxt);
        if constexpr (Epi::NPRE > 0) E.prefetch(pre, cur, wr, fr);
        const char* nA = has_next ? nxt.A : cA; const char* nB = has_next ? nxt.B : cB;
        unsigned nrid[2][2]; int nleft = 0;
        if constexpr (GATHER) {
            int t2 = tid; asm volatile("" : "+v"(t2));
            if (has_next) { nleft = S.rows_left(nxt);
#pragma unroll
                for (int i = 0; i < 2; ++i) { int R, C; stage_rc(t2 * 16 + i * 8192, R, C);
#pragma unroll
                    for (int h = 0; h < 2; ++h) asm volatile("global_load_dword %0, %1, off" : "=v"(nrid[h][i]) : "v"(S.arow_ptr(nxt, h * HALF + R)) : "memory"); }
            } else {
#pragma unroll
                for (int i = 0; i < 2; ++i)
#pragma unroll
                    for (int h = 0; h < 2; ++h) { nvA[h][i] = vA[h][i]; nrid[h][i] = 0u; }
            }
        }
#pragma unroll 1
        for (int t = 0; t < nt; t += 2) {
            const bool last = (t == nt - 2);
            const char* a1 = cA + (size_t)(t + 1) * kstep;
            const char* a2 = last ? nA : cA + (size_t)(t + 2) * kstep; const char* b2 = last ? nB : cB + (size_t)(t + 2) * kstep;
            const char* a3 = a2 + kstep; const char* b3 = b2 + kstep;
            unsigned wA[2][2];
            if constexpr (GATHER) {
                if (last && has_next) {
                    int t2 = tid; asm volatile("" : "+v"(t2));
#pragma unroll
                    for (int i = 0; i < 2; ++i) { int R, C; stage_rc(t2 * 16 + i * 8192, R, C);
#pragma unroll
                        for (int h = 0; h < 2; ++h) { unsigned r_ = nrid[h][i]; asm volatile("" : "+v"(r_));
                            nvA[h][i] = ((h * HALF + R) < nleft ? (r_ >> 1) : 0u) * (unsigned)(K * 2) + (unsigned)C * 2u; } }
                }
            }
#pragma unroll
            for (int h = 0; h < 2; ++h)
#pragma unroll
                for (int i = 0; i < 2; ++i) wA[h][i] = GATHER ? (last ? nvA[h][i] : vA[h][i]) : vA[h][i];
            PG8_LDB(B0, 0, 0); PG8_LDB(B1, 0, 1); PG8_SCHED; PG8_LDA(At, 0, 0); PG8_STAGE(PG8_SA(1, 1), a1, vA[1]);
            PG8_WAIT_V(8); PG8_WAIT_L(0); PG8_BAR; PG8_MMA(0, 0, At, B0); PG8_MMA(0, 1, At, B1); PG8_BAR; PG8_SCHED;
            PG8_LDA(At, 0, 1); PG8_STAGE(PG8_SB(0, 0), b2, voffB); PG8_STAGE(PG8_SB(0, 1), b2 + hstep, voffB); PG8_STAGE(PG8_SA(0, 0), a2, wA[0]);
            PG8_WAIT_V(8); PG8_WAIT_L(0); PG8_BAR; PG8_MMA(1, 0, At, B0); PG8_MMA(1, 1, At, B1); PG8_BAR; PG8_SCHED;
            PG8_LDB(B0, 1, 0); PG8_LDB(B1, 1, 1); PG8_SCHED; PG8_LDA(At, 1, 0); PG8_STAGE(PG8_SA(0, 1), a2, wA[1]);
            PG8_WAIT_V(8); PG8_WAIT_L(0); PG8_BAR; PG8_MMA(0, 0, At, B0); PG8_MMA(0, 1, At, B1); PG8_BAR; PG8_SCHED;
            PG8_LDA(At, 1, 1); PG8_STAGE(PG8_SB(1, 0), b3, voffB); PG8_STAGE(PG8_SB(1, 1), b3 + hstep, voffB); PG8_STAGE(PG8_SA(1, 0), a3, wA[0]);
            PG8_WAIT_V(8); PG8_WAIT_L(0); PG8_BAR; PG8_MMA(1, 0, At, B0); PG8_MMA(1, 1, At, B1); PG8_BAR; PG8_SCHED;
        }
        if (wr == 0) PG8_BAR;
        if constexpr (FP8) asm volatile("s_nop 15\n\ts_nop 7" ::: "memory");
        if constexpr (Epi::NPRE > 0) E(acc, cur, wr, wc, fr, fq, pre); else E(acc, cur, wr, wc, fr, fq);
        if (!has_next) break;
#pragma unroll
        for (int a = 0; a < 2; ++a)
#pragma unroll
            for (int b = 0; b < 2; ++b)
#pragma unroll
                for (int m = 0; m < 4; ++m)
#pragma unroll
                    for (int n = 0; n < 2; ++n) acc[a][b][m][n] = (f32x4){0.f, 0.f, 0.f, 0.f};
        cur = nxt; cA = nA; cB = nB; ++ui;
        if constexpr (GATHER) {
#pragma unroll
            for (int h = 0; h < 2; ++h)
#pragma unroll
                for (int i = 0; i < 2; ++i) vA[h][i] = nvA[h][i];
        }
        if (wr == 1) PG8_BAR;
    }
    PG8_WAIT_V(0);
    PG8_BAR;
#undef PG8_SA
#undef PG8_SB
#undef PG8_STAGE
#undef PG8_LDA
#undef PG8_LDB
#undef PG8_MMA
#undef PG8_LD8
#undef PG8_WAIT_V
#undef PG8_WAIT_L
#undef PG8_BAR
#undef PG8_SCHED
}
}


#define XB_TMO      128
#define XB_XCNT(j)  (256  + 64 * (j))
#define XB_XSUB(j)  (1280 + 64 * (j))
#define XB_XGEN(j)  (2304 + 64 * (j))
#define XB_TOP      3328
#define XB_TOPGEN   3392
#define XCD_BAR_WORDS 3456
#define XB_SPIN_CAP (1u << 20)
DI unsigned xb_ld(unsigned* p)              { return __hip_atomic_load(p, __ATOMIC_RELAXED, __HIP_MEMORY_SCOPE_AGENT); }
DI unsigned xb_add(unsigned* p, unsigned v) { return __hip_atomic_fetch_add(p, v, __ATOMIC_RELAXED, __HIP_MEMORY_SCOPE_AGENT); }
DI unsigned xb_xcc_id() { return (unsigned)__builtin_amdgcn_s_getreg((3 << 11) | 20) & 0xFu; }
#define XB_SPIN(cond, bar) do { unsigned _sp = 0; while (cond) { __builtin_amdgcn_s_sleep(1); \
    if ((++_sp & 255u) == 0u) { if (xb_ld(&(bar)[XB_TMO])) break; if (_sp > XB_SPIN_CAP) { atomicAdd(&(bar)[XB_TMO], 1u); break; } } } } while (0)
struct XcdBarrier { unsigned* bar; unsigned x; volatile LAS unsigned* st; };
DI XcdBarrier xcd_barrier_post(unsigned* bar, volatile LAS unsigned* st, bool leader) {
    XcdBarrier b; b.bar = bar; b.x = xb_xcc_id(); b.st = st;
    if (leader) (void)xb_add(&bar[XB_XCNT(b.x)], 1u);
    return b;
}
DI void xcd_barrier_complete(unsigned* bar, unsigned x, unsigned& nloc, unsigned& nx) {
    const unsigned G = gridDim.x;
    unsigned sum, cnt, mine, sp = 0u;
    for (;;) {
        sum = 0u; cnt = 0u; mine = 0u;
#pragma unroll
        for (unsigned j = 0; j < 16; ++j) { const unsigned c = xb_ld(&bar[XB_XCNT(j)]); sum += c; cnt += (c > 0u) ? 1u : 0u; mine = (j == x) ? c : mine; }
        if (sum == G) break;
        __builtin_amdgcn_s_sleep(1);
        if ((++sp & 255u) == 0u) { if (xb_ld(&bar[XB_TMO])) break; if (sp > XB_SPIN_CAP) { atomicAdd(&bar[XB_TMO], 1u); break; } }
    }
    nloc = mine > 0u ? mine : 1u; nx = cnt > 0u ? cnt : 1u;
}
DI void xcd_barrier(const XcdBarrier& b, bool leader) {
    asm volatile("s_waitcnt vmcnt(0)" ::: "memory");
    __syncthreads();
    if (leader) {
        unsigned* bar = b.bar;
        __builtin_amdgcn_s_waitcnt(0);
        unsigned nloc = b.st[0], nx = b.st[1];
        if (nloc == 0u) { xcd_barrier_complete(bar, b.x, nloc, nx); b.st[0] = nloc; b.st[1] = nx; }
        const unsigned old = xb_add(&bar[XB_XSUB(b.x)], 1u);
        const unsigned gen = old / nloc;
        if (old + 1u == (gen + 1u) * nloc) {
            __builtin_amdgcn_fence(__ATOMIC_RELEASE, "agent");
            asm volatile("s_waitcnt vmcnt(0)" ::: "memory");
            const unsigned og = xb_add(&bar[XB_TOP], 1u);
            const unsigned tg = og / nx;
            if (og + 1u == (tg + 1u) * nx) xb_add(&bar[XB_TOPGEN], 1u);
            else XB_SPIN(xb_ld(&bar[XB_TOPGEN]) == tg, bar);
            __builtin_amdgcn_fence(__ATOMIC_ACQUIRE, "agent");
            xb_add(&bar[XB_XGEN(b.x)], 1u);
            asm volatile("s_waitcnt vmcnt(0)" ::: "memory");
        } else {
            XB_SPIN(xb_ld(&bar[XB_XGEN(b.x)]) == gen, bar);
            __builtin_amdgcn_fence(__ATOMIC_ACQUIRE, "agent");
            asm volatile("s_waitcnt vmcnt(0)" ::: "memory");
        }
    }
    __syncthreads();
}

struct Args { const float* in[24]; float* out; unsigned char* ws; int ph_lo, ph_hi, dupk, dbg; };
struct Frame {
    lptr lds; int wave, vcu, G, bx;
    unsigned char* ws;
};

template <class RMap, bool FP8OUT = false>
DI void p0_transpose_item(const float* W, int ldn, int K, bf16_t* WT, LAS float* scr, int k0, int n0, int lane, const float* kscale, const RMap& rmap) {
    f32x4 v[8]; float ksc[8];
    const int r8 = lane >> 3, c4 = (lane & 7) * 4;
#pragma unroll
    for (int i = 0; i < 8; ++i) { v[i] = __builtin_nontemporal_load((const f32x4*)(W + (size_t)(k0 + r8 + 8 * i) * ldn + n0 + c4)); ksc[i] = kscale ? kscale[k0 + r8 + 8 * i] : 1.f; }
#pragma unroll
    for (int i = 0; i < 8; ++i) { LAS float* d = scr + (r8 + 8 * i) * 33 + c4; d[0] = v[i][0] * ksc[i]; d[1] = v[i][1] * ksc[i]; d[2] = v[i][2] * ksc[i]; d[3] = v[i][3] * ksc[i]; }
    asm volatile("s_waitcnt lgkmcnt(0)" ::: "memory");
    const int c = lane & 7;
#pragma unroll
    for (int j = 0; j < 4; ++j) { const int n = (lane >> 3) + 8 * j; const LAS float* s = scr + (8 * c) * 33 + n; float cs; const long orow = rmap(n0 + n, cs);
        if constexpr (FP8OUT) { u32x2 o; o.x = pk4_fp8(s[0 * 33] * cs, s[1 * 33] * cs, s[2 * 33] * cs, s[3 * 33] * cs); o.y = pk4_fp8(s[4 * 33] * cs, s[5 * 33] * cs, s[6 * 33] * cs, s[7 * 33] * cs);
            *(u32x2*)((unsigned char*)WT + (size_t)orow * K + k0 + 8 * c) = o; }
        else {
        u32x4 o; o.x = pk2(s[0 * 33] * cs, s[1 * 33] * cs); o.y = pk2(s[2 * 33] * cs, s[3 * 33] * cs); o.z = pk2(s[4 * 33] * cs, s[5 * 33] * cs); o.w = pk2(s[6 * 33] * cs, s[7 * 33] * cs);
        *(u32x4*)(WT + (size_t)orow * K + k0 + 8 * c) = o; } }
    asm volatile("s_waitcnt lgkmcnt(0)" ::: "memory");
}
struct RMapId { DI long operator()(int n, float& cs) const { cs = 1.f; return n; } };
struct RMapScale { float s; DI long operator()(int n, float& cs) const { cs = s; return n; } };
struct RMapKV { DI long operator()(int n, float& cs) const { cs = n < DM ? 0.015625f : 1.f; return n; } };
struct RMapWin {
    DI long operator()(int n, float& cs) const {
        cs = (n >= 256 && n < 512) ? 0.125f : 1.f;
        if (n < 512) { const int d = n & 63, p = (d < 32) ? 2 * d : 2 * (d - 32) + 1; return (n & ~63) + p; }
        return n;
    }
};
struct RMapGU { int up; DI long operator()(int n, float& cs) const { cs = 1.f; return (long)(n >> 7) * 256 + up * 128 + (n & 127); } };

DI void p0_prologue(Frame& F, const Args& a) {
    unsigned char* ws = F.ws;
    LAS float* scr = (LAS float*)(F.lds + F.wave * 16384);
    const int gw = F.vcu * NWAVES + F.wave, NGW = F.G * NWAVES, lane = lane_id(), tid0 = F.wave * 64 + lane;
    const float* g_mix = a.in[2]; const float* g_xa = a.in[10]; const float* g_mem = a.in[11]; const float* g_moe = a.in[15];
    constexpr int I_WIN = 16 * 112, I_SQ = 16 * 32, I_WKV = 16 * 64, I_GU = 32 * 16 * 16, I_DN = 32 * 8 * 32;
    constexpr int NITEMS = I_WIN + 3 * I_SQ + I_WKV;
    for (int it = gw; it < NITEMS; it += NGW) {
        int r = it;
        if (r < I_WIN) { p0_transpose_item(a.in[3], INW, DM, (bf16_t*)(ws + WS_WIN), scr, 64 * (r / 112), 32 * (r % 112), lane, g_mix, RMapWin{}); continue; } r -= I_WIN;
        if (r < I_SQ) { p0_transpose_item(a.in[9], DM, DM, (bf16_t*)(ws + WS_WOUT), scr, 64 * (r / 32), 32 * (r % 32), lane, nullptr, RMapId{}); continue; } r -= I_SQ;
        if (r < I_SQ) { p0_transpose_item<RMapScale, true>(a.in[12], DM, DM, (bf16_t*)(ws + WS_WQ), scr, 64 * (r / 32), 32 * (r % 32), lane, g_xa, RMapScale{0.0625f * 1.4426950408889634f * 512.f}); continue; }   r -= I_SQ;
        if (r < I_SQ) { p0_transpose_item<RMapScale, true>(a.in[14], DM, DM, (bf16_t*)(ws + WS_WO), scr, 64 * (r / 32), 32 * (r % 32), lane, nullptr, RMapScale{32.f}); continue; }   r -= I_SQ;
        { p0_transpose_item<RMapScale, true>(a.in[13], 2 * DM, DM, (bf16_t*)(ws + WS_WKV), scr, 64 * (r / 64), 32 * (r % 64), lane, g_mem, RMapScale{32.f}); }
    }
    {
        bf16_t* hi = (bf16_t*)(ws + WS_WR); bf16_t* lo = hi + 48 * 1024;
        const float* wg = a.in[16]; const float* wr_ = a.in[18];
        for (int idx = (F.vcu * NTHR + tid0); idx < 48 * 1024; idx += F.G * NTHR) {
            const int row = idx >> 10, k = idx & 1023; float v = 0.f;
            if (row < 32) { const int g = (row & 15) >> 2, i = (row & 3) + 4 * (row >> 4); v = wr_[(size_t)k * 32 + 8 * g + i] * g_moe[k]; }
            else if ((row & 3) == 0) { v = wg[(size_t)k * 4 + ((row - 32) >> 2)] * g_moe[k]; }
            const unsigned h = pk2(v, 0.f) & 0xffffu; const float r = v - bf2f((unsigned short)h);
            hi[idx] = (bf16_t)h; lo[idx] = (bf16_t)(pk2(r, 0.f) & 0xffffu);
        }
    }
    {
        f32x2* tab = (f32x2*)(ws + WS_ROPE);
        for (int idx = (F.vcu * NTHR + tid0); idx < SEQ * 32; idx += F.G * NTHR) {
            const int pos = idx >> 5, i = idx & 31; const float inv = powf(10000.0f, -(float)i / 32.0f); const float ang = (float)pos * inv;
            tab[idx] = (f32x2){cosf(ang), sinf(ang)};
        }
    }
    {
        float wgt[4][4][8];
#pragma unroll
        for (int jj = 0; jj < 4; ++jj)
#pragma unroll
            for (int c = 0; c < 4; ++c) { const int k = 256 * jj + 4 * lane + c; const float g = g_mix[k];
                const f32x4 w0 = *(const f32x4*)(a.in[3] + (size_t)k * INW + NP1), w1 = *(const f32x4*)(a.in[3] + (size_t)k * INW + NP1 + 4);
#pragma unroll
                for (int j = 0; j < 4; ++j) { wgt[jj][c][j] = w0[j] * g; wgt[jj][c][4 + j] = w1[j] * g; } }
        const float gb = a.in[7][lane & 7];
        bf16_t* xn0 = (bf16_t*)(ws + WS_XN0); float* gates = (float*)(ws + WS_GATES);
        f32x4 v[4];
        if (gw < NT) { const f32x4* xr = (const f32x4*)(a.in[0] + (size_t)gw * DM) + lane;
#pragma unroll
            for (int j = 0; j < 4; ++j) v[j] = __builtin_nontemporal_load(&xr[64 * j]); }
        for (int m = gw; m < NT; m += NGW) {
            f32x4 vn[4]; const int mn = (m + NGW < NT) ? m + NGW : m;
            { const f32x4* xr = (const f32x4*)(a.in[0] + (size_t)mn * DM) + lane;
#pragma unroll
                for (int j = 0; j < 4; ++j) vn[j] = __builtin_nontemporal_load(&xr[64 * j]); }
            float s = 0.f;
#pragma unroll
            for (int j = 0; j < 4; ++j) s += (v[j].x * v[j].x + v[j].y * v[j].y) + (v[j].z * v[j].z + v[j].w * v[j].w);
            const float rstd = rsqrtf(wave_sum(s) * (1.f / DM) + EPS);
            float gacc[8];
#pragma unroll
            for (int j = 0; j < 8; ++j) gacc[j] = 0.f;
#pragma unroll
            for (int jj = 0; jj < 4; ++jj)
#pragma unroll
                for (int c = 0; c < 4; ++c)
#pragma unroll
                    for (int j = 0; j < 8; ++j) gacc[j] += v[jj][c] * wgt[jj][c][j];
            unsigned long long* o8 = (unsigned long long*)(xn0 + (size_t)m * DM) + lane;
#pragma unroll
            for (int j = 0; j < 4; ++j) o8[64 * j] = (unsigned long long)pk2(v[j].x * rstd, v[j].y * rstd) | ((unsigned long long)pk2(v[j].z * rstd, v[j].w * rstd) << 32);
            float r4[4], r2[2], r1;
#pragma unroll
            for (int j = 0; j < 4; ++j) { const float mine = (lane & 1) ? gacc[2 * j + 1] : gacc[2 * j], oth = (lane & 1) ? gacc[2 * j] : gacc[2 * j + 1]; r4[j] = mine + __shfl_xor(oth, 1); }
#pragma unroll
            for (int j = 0; j < 2; ++j) { const float mine = (lane & 2) ? r4[2 * j + 1] : r4[2 * j], oth = (lane & 2) ? r4[2 * j] : r4[2 * j + 1]; r2[j] = mine + __shfl_xor(oth, 2); }
            { const float mine = (lane & 4) ? r2[1] : r2[0], oth = (lane & 4) ? r2[0] : r2[1]; r1 = mine + __shfl_xor(oth, 4); }
            r1 += __shfl_xor(r1, 8); r1 += __shfl_xor(r1, 16); r1 += __shfl_xor(r1, 32);
            if (lane < 8) gates[(size_t)m * 8 + lane] = r1 * rstd + gb;
            if (lane == 8) ((float*)(ws + WS_RMS))[m] = __builtin_amdgcn_rcpf(rstd);
#pragma unroll
            for (int j = 0; j < 4; ++j) v[j] = vn[j];
        }
    }
    {
        unsigned char* memn = ws + WS_MEMN;
        for (int m = gw; m < MEMT; m += NGW) {
            const f32x4* xr = (const f32x4*)(a.in[1] + (size_t)m * DM) + lane;
            f32x4 v[4]; float s = 0.f;
#pragma unroll
            for (int j = 0; j < 4; ++j) { v[j] = xr[64 * j]; s += (v[j].x * v[j].x + v[j].y * v[j].y) + (v[j].z * v[j].z + v[j].w * v[j].w); }
            const float rstd = rsqrtf(wave_sum(s) * (1.f / DM) + EPS);
            unsigned* o4 = (unsigned*)(memn + (size_t)m * DM) + lane;
#pragma unroll
            for (int j = 0; j < 4; ++j) o4[64 * j] = pk4_fp8(v[j].x * rstd, v[j].y * rstd, v[j].z * rstd, v[j].w * rstd);
        }
    }
}


struct SchedQ {
    int G, vcu; const char* A; const char* B; int K;
    DI bool next(int i, pg8::Unit& u) const { const int p = vcu + (i >> 2) * G; if (p >= 256) return false;
        const int pm = 8 * (p >> 3) + 4 * (p & 1) + (i & 3), pn = (p >> 1) & 3;
        u.A = A + (size_t)pm * 256 * K * 2; u.B = B + (size_t)pn * 256 * K * 2; u.pm = pm; u.pn = pn; u.tag = 0; u.aux = 0; return true; }
    DI unsigned arow(const pg8::Unit&, int) const { return 0u; }
};
struct SchedDense {
    pg8::DenseOrder o; const char* A; const char* B; int K;
    DI bool next(int i, pg8::Unit& u) const { int pm, pn; if (!o.tile(i, pm, pn)) return false; u.A = A + (size_t)pm * 256 * K * 2; u.B = B + (size_t)pn * 256 * K * 2; u.pm = pm; u.pn = pn; u.tag = 0; u.aux = 0; return true; }
    DI unsigned arow(const pg8::Unit&, int) const { return 0u; }
};
struct SchedP1 {
    pg8::DenseOrder o1, o2; const char *A1, *B1, *A2, *B2; int n1;
    DI bool next(int i, pg8::Unit& u) const {
        int pm, pn;
        if (i < n1) { o1.tile(i, pm, pn); u.A = A1 + (size_t)pm * 256 * DM * 2; u.B = B1 + (size_t)pn * 256 * DM * 2; u.pm = pm; u.pn = pn; u.tag = 0; u.aux = 0; return true; }
        if (!o2.tile(i - n1, pm, pn)) return false;
        u.A = A2 + (size_t)pm * 256 * DM * 2; u.B = B2 + (size_t)pn * 256 * DM * 2; u.pm = pm; u.pn = pn; u.tag = 1; u.aux = 0; return true;
    }
    DI unsigned arow(const pg8::Unit&, int) const { return 0u; }
};

struct SchedKV {
    int first, step; const char *A, *B;
    DI bool next(int i, pg8::Unit& u) const { const int li = first + i * step; if (li >= 256) return false; u.pm = li >> 3; u.pn = li & 7; u.A = A + (size_t)u.pm * 256 * DM; u.B = B + (size_t)u.pn * 256 * DM;
        if (u.pn >= 4) { const char* t = u.A; u.A = u.B; u.B = t; }
        u.tag = 1; u.aux = 0; return true; }
    DI unsigned arow(const pg8::Unit&, int) const { return 0u; }
};
struct EpiP1 {
    static constexpr int NPRE = 0;
    bf16_t* proj; bf16_t* kvb; const f32x4* rope;
    DI void operator()(const f32x4 (&acc)[2][2][4][2], const pg8::Unit& u, int wr, int wc, int fr, int fq) const {
        asm volatile("" : "+v"(fr), "+v"(fq));
        const int row0 = u.pm * 256 + wr * 64 + fr, col0 = u.pn * 256 + wc * 32 + 8 * fq;
        const int mode = (u.tag == 1) ? 0 : (u.pn < 2 ? 1 : ((u.pn == 4 || u.pn == 5) ? 2 : ((u.pn == 12 || u.pn == 13) ? 3 : 0)));
        bf16_t* base = (u.tag == 1) ? kvb + ((size_t)(((u.pn >> 2) * NB + u.pm) * 4 + (u.pn & 3)) << 16) - (size_t)u.pm * 256 * 256 - (size_t)u.pn * 256 : proj; const int ldc = (u.tag == 1) ? 256 : NP1;
        f32x4 rt[2][4][2];
        if (mode == 1) {
#pragma unroll
            for (int ai = 0; ai < 2; ++ai)
#pragma unroll
                for (int m = 0; m < 4; ++m) { const f32x4* tp = rope + (size_t)((row0 + ai * 128 + m * 16) & (SEQ - 1)) * 16 + ((wc & 1) * 16 + 4 * fq) / 2; rt[ai][m][0] = tp[0]; rt[ai][m][1] = tp[1]; }
        }
        SCHED_FENCE();
#pragma unroll
        for (int ai = 0; ai < 2; ++ai)
#pragma unroll
            for (int m = 0; m < 4; ++m) {
                const int grow = row0 + ai * 128 + m * 16; bf16_t* rowp = base + (size_t)grow * ldc + col0;
                f32x4 t0 = {1.f, 0.f, 1.f, 0.f}, t1 = {1.f, 0.f, 1.f, 0.f};
                if (mode == 1) { t0 = rt[ai][m][0]; t1 = rt[ai][m][1]; }
#pragma unroll
                for (int bj = 0; bj < 2; ++bj) {
                    f32x4 v0 = acc[ai][bj][m][0], v1 = acc[ai][bj][m][1];
                    if (mode == 1) {
                        f32x4 r0, r1;
                        r0[0] = v0[0] * t0[0] - v0[1] * t0[1]; r0[1] = v0[0] * t0[1] + v0[1] * t0[0];
                        r0[2] = v0[2] * t0[2] - v0[3] * t0[3]; r0[3] = v0[2] * t0[3] + v0[3] * t0[2];
                        r1[0] = v1[0] * t1[0] - v1[1] * t1[1]; r1[1] = v1[0] * t1[1] + v1[1] * t1[0];
                        r1[2] = v1[2] * t1[2] - v1[3] * t1[3]; r1[3] = v1[2] * t1[3] + v1[3] * t1[2];
                        v0 = r0; v1 = r1;
                    } else if (mode == 2) {
#pragma unroll
                        for (int j = 0; j < 4; ++j) { v0[j] = silu_f(v0[j]); v1[j] = silu_f(v1[j]); }
                    } else if (mode == 3) {
#pragma unroll
                        for (int j = 0; j < 4; ++j) { v0[j] = sigm_f(v0[j]); v1[j] = sigm_f(v1[j]); }
                    }
                    u32x4 w; w.x = pk2(v0[0], v0[1]); w.y = pk2(v0[2], v0[3]); w.z = pk2(v1[0], v1[1]); w.w = pk2(v1[2], v1[3]);
                    __builtin_nontemporal_store(w, (u32x4*)(rowp + bj * 128));
                }
            }
    }
};
struct EpiKV8 {
    static constexpr int NPRE = 0;
    unsigned char* kv8;
    DI void operator()(const f32x4 (&acc)[2][2][4][2], const pg8::Unit& u, int wr, int wc, int fr, int fq) const {
        asm volatile("" : "+v"(fr), "+v"(fq));
        unsigned char* blk = kv8 + ((size_t)(((u.pn >> 2) * NB + u.pm) * 4 + (u.pn & 3)) << 16);
        const int odd = fq & 1;
#pragma unroll
        for (int ai = 0; ai < 2; ++ai)
#pragma unroll
            for (int bj = 0; bj < 2; ++bj) { u32x2 w8[4];
#pragma unroll
                for (int m = 0; m < 4; ++m) { const f32x4 v0 = acc[ai][bj][m][0], v1 = acc[ai][bj][m][1]; w8[m].x = pk4_fp8(v0[0], v0[1], v0[2], v0[3]); w8[m].y = pk4_fp8(v1[0], v1[1], v1[2], v1[3]); }
#pragma unroll
                for (int mp = 0; mp < 2; ++mp) __builtin_nontemporal_store(pair16(w8[2 * mp], w8[2 * mp + 1]), (u32x4*)(blk + (ai * 128 + wr * 64 + (2 * mp + odd) * 16 + fr) * 256 + bj * 128 + wc * 32 + 8 * (fq - odd))); }
    }
};
struct EpiP3 {
    static constexpr int NPRE = 0;
    const bf16_t* xn0; const float* rms; bf16_t* x1b; float* ssq; unsigned char* x1q8;
    DI void operator()(const f32x4 (&acc)[2][2][4][2], const pg8::Unit& u, int wr, int wc, int fr, int fq) const {
        asm volatile("" : "+v"(fr), "+v"(fq));
        const int row0 = u.pm * 256 + wr * 64 + fr, col0 = u.pn * 256 + wc * 32 + 8 * fq;
#pragma unroll
        for (int ai = 0; ai < 2; ++ai) {
            u32x4 xv[4][2]; float rm[4];
#pragma unroll
            for (int m = 0; m < 4; ++m) { rm[m] = rms[row0 + ai * 128 + m * 16];
#pragma unroll
                for (int bj = 0; bj < 2; ++bj) xv[m][bj] = *(const u32x4*)(xn0 + (size_t)(row0 + ai * 128 + m * 16) * DM + col0 + bj * 128); }
            SCHED_FENCE();
            u32x2 w8s[4][2];
#pragma unroll
            for (int m = 0; m < 4; ++m) {
                const int grow = row0 + ai * 128 + m * 16; float s = 0.f;
#pragma unroll
                for (int bj = 0; bj < 2; ++bj) {
                    const u32x4 r = xv[m][bj]; const float rmm = rm[m];
                    const f32x4 v0 = acc[ai][bj][m][0] + (f32x4){bflo(r.x), bfhi(r.x), bflo(r.y), bfhi(r.y)} * rmm, v1 = acc[ai][bj][m][1] + (f32x4){bflo(r.z), bfhi(r.z), bflo(r.w), bfhi(r.w)} * rmm;
                    u32x4 w; w.x = pk2(v0[0], v0[1]); w.y = pk2(v0[2], v0[3]); w.z = pk2(v1[0], v1[1]); w.w = pk2(v1[2], v1[3]);
                    __builtin_nontemporal_store(w, (u32x4*)(x1b + (size_t)grow * DM + col0 + bj * 128));
                    w8s[m][bj].x = pk4_fp8(v0[0], v0[1], v0[2], v0[3]); w8s[m][bj].y = pk4_fp8(v1[0], v1[1], v1[2], v1[3]);
                    const float a0 = bflo(w.x), a1 = bfhi(w.x), a2 = bflo(w.y), a3 = bfhi(w.y), a4 = bflo(w.z), a5 = bfhi(w.z), a6 = bflo(w.w), a7 = bfhi(w.w);
                    s += (a0 * a0 + a1 * a1) + (a2 * a2 + a3 * a3) + (a4 * a4 + a5 * a5) + (a6 * a6 + a7 * a7);
                }
                s += __shfl_xor(s, 16); s += __shfl_xor(s, 32);
                if (fq == 0) ssq[(size_t)grow * 16 + u.pn * 4 + wc] = s;
            }
            { const int odd = fq & 1;
#pragma unroll
              for (int mp = 0; mp < 2; ++mp)
#pragma unroll
                for (int bj = 0; bj < 2; ++bj) *(u32x4*)(x1q8 + (size_t)(row0 + ai * 128 + (2 * mp + odd) * 16) * DM + col0 - 8 * odd + bj * 128) = pair16(w8s[2 * mp][bj], w8s[2 * mp + 1][bj]); }
            SCHED_FENCE();
        }
    }
};

constexpr int RQ_OFF = 0, RK_OFF = 18432, RV_OFF = 36864, RRT_OFF = 73728, RNW_OFF = 92160, RSTG_OFF = 94208;
DI void headnorm_store(f32x4 (&x)[8], const LAS float* nw, const u32x4 (&gq)[4], lptr stg, bf16_t* outw, int lane, int exor) {
    const int fr = lane & 15, fq = lane >> 4;
#pragma unroll
    for (int it = 0; it < 4; ++it) *(LAS u32x4*)(stg + (fq + 4 * it) * 272 + 16 * fr) = gq[it];
    float s = 0.f;
#pragma unroll
    for (int eb = 0; eb < 8; ++eb) s += (x[eb][0] + x[eb][1]) + (x[eb][2] + x[eb][3]);
    s += __shfl_xor(s, 16); s += __shfl_xor(s, 32);
    const float mu = s * (1.f / 128.f); float q = 0.f;
#pragma unroll
    for (int eb = 0; eb < 8; ++eb) { x[eb] = x[eb] - mu; q += (x[eb][0] * x[eb][0] + x[eb][1] * x[eb][1]) + (x[eb][2] * x[eb][2] + x[eb][3] * x[eb][3]); }
    q += __shfl_xor(q, 16); q += __shfl_xor(q, 32);
    const float rs = rsqrtf(q * (1.f / 128.f) + EPS);
#pragma unroll
    for (int eb = 0; eb < 8; ++eb) {
        const int e0 = 16 * (eb ^ exor) + 4 * fq;
        const f32x4 wv = *(const LAS f32x4*)(nw + e0); const u32x2 gv = *(const LAS u32x2*)(stg + fr * 272 + e0 * 2);
        u32x2 o; o.x = pk2(x[eb][0] * rs * wv[0] * bflo(gv.x), x[eb][1] * rs * wv[1] * bfhi(gv.x)); o.y = pk2(x[eb][2] * rs * wv[2] * bflo(gv.y), x[eb][3] * rs * wv[3] * bfhi(gv.y));
        *(LAS u32x2*)(stg + fr * 272 + e0 * 2) = o;
    }
#pragma unroll
    for (int it = 0; it < 4; ++it) { const u32x4 v = *(const LAS u32x4*)(stg + (fq + 4 * it) * 272 + 16 * fr); *(u32x4*)(outw + (size_t)(fq + 4 * it) * DM + 8 * fr) = v; }
}
DI void ret_item(Frame& F, const Args& a, int b, int h) {
    const lptr L = F.lds; const int w = F.wave;
    const bf16_t* proj = (const bf16_t*)(F.ws + WS_PROJ); bf16_t* mix = (bf16_t*)(F.ws + WS_MIX);
    const float lg2 = log1pf(-exp2f(-5.f - (float)h)) * 1.4426950408889634f;
    const float g128 = exp2f(128.f * lg2);
    const int db = w >> 1, ebase = 4 * (w & 1);
    LAS float* nw = (LAS float*)(L + RNW_OFF);
    { const int t_ = F.wave * 64 + lane_id(); if (t_ < 128) nw[t_] = a.in[4][h * 128 + t_]; }
    f32x4 Racc[4];
#pragma unroll
    for (int t = 0; t < 4; ++t) Racc[t] = (f32x4){0.f, 0.f, 0.f, 0.f};
    for (int i = F.wave * 64 + lane_id(); i < 18432 / 16; i += NTHR) *(LAS u32x4*)(L + RRT_OFF + i * 16) = (u32x4){0u, 0u, 0u, 0u};
    u32x4 pq[2], pk[2], pv[4];
    {
        const int tid = F.wave * 64 + lane_id(); const size_t row0 = (size_t)b * SEQ;
#pragma unroll
        for (int i = 0; i < 2; ++i) { const int p = tid + i * NTHR, r = p >> 3, ch = p & 7; const bf16_t* src = proj + (row0 + r) * NP1 + h * 64 + ch * 8; pq[i] = *(const u32x4*)src; pk[i] = *(const u32x4*)(src + 256); }
#pragma unroll
        for (int i = 0; i < 4; ++i) { const int p = tid + i * NTHR, r = p >> 4, ch = p & 15; pv[i] = *(const u32x4*)(proj + (row0 + r) * NP1 + 512 + h * 128 + ch * 8); }
    }
    for (int c = 0; c < 16; ++c) {
        const size_t row0 = (size_t)b * SEQ + c * 128;
        int tid = F.wave * 64 + lane_id(); asm volatile("" : "+v"(tid));
        const int lane = tid & 63, fr = lane & 15, fq = lane >> 4;
        __syncthreads();
        if (c > 0) {
#pragma unroll
            for (int t = 0; t < 4; ++t) { u32x2 pk_; pk_.x = pk2(Racc[t][0], Racc[t][1]); pk_.y = pk2(Racc[t][2], Racc[t][3]);
                *(LAS u32x2*)(L + RRT_OFF + (16 * (ebase + t) + fr) * 144 + (16 * db + 4 * fq) * 2) = pk_; }
        }
#pragma unroll
        for (int i = 0; i < 2; ++i) { const int p = tid + i * NTHR, r = p >> 3, ch = p & 7;
            *(LAS u32x4*)(L + RQ_OFF + r * 144 + ch * 16) = pq[i]; *(LAS u32x4*)(L + RK_OFF + r * 144 + ch * 16) = pk[i]; }
#pragma unroll
        for (int i = 0; i < 4; ++i) { const int p = tid + i * NTHR, r = p >> 4, ch = p & 15; u32x4 v = pv[i];
            const float sc = exp2f((float)(127 - r) * lg2);
            v.x = pk2(bflo(v.x) * sc, bfhi(v.x) * sc); v.y = pk2(bflo(v.y) * sc, bfhi(v.y) * sc); v.z = pk2(bflo(v.z) * sc, bfhi(v.z) * sc); v.w = pk2(bflo(v.w) * sc, bfhi(v.w) * sc);
            *(LAS u32x4*)(L + RV_OFF + r * 288 + ch * 16) = v; }
        __syncthreads();
        {
            const size_t rown = (size_t)b * SEQ + (c < 15 ? c + 1 : c) * 128;
#pragma unroll
            for (int i = 0; i < 2; ++i) { const int p = tid + i * NTHR, r = p >> 3, ch = p & 7; const bf16_t* src = proj + (rown + r) * NP1 + h * 64 + ch * 8; pq[i] = *(const u32x4*)src; pk[i] = *(const u32x4*)(src + 256); }
#pragma unroll
            for (int i = 0; i < 4; ++i) { const int p = tid + i * NTHR, r = p >> 4, ch = p & 15; pv[i] = *(const u32x4*)(proj + (rown + r) * NP1 + 512 + h * 128 + ch * 8); }
        }
        const size_t grow = row0 + 16 * w + fr;
        u32x4 gq[4];
#pragma unroll
        for (int it = 0; it < 4; ++it) gq[it] = *(const u32x4*)(proj + (row0 + 16 * w + fq + 4 * it) * NP1 + 1024 + h * 128 + 8 * fr);
        bf16x8 qf[2];
#pragma unroll
        for (int ks = 0; ks < 2; ++ks) qf[ks] = lds16(L + RQ_OFF + (16 * w + fr) * 144 + (32 * ks + 8 * fq) * 2);
        f32x4 S[8];
        {
            bf16x8 kf[2][4];
#pragma unroll
            for (int j = 0; j < 4; ++j) kf[0][j] = lds16(L + RK_OFF + (16 * (j >> 1) + fr) * 144 + (32 * (j & 1) + 8 * fq) * 2);
#pragma unroll
            for (int g = 0; g < 4; ++g) {
                if (g < 3) {
#pragma unroll
                    for (int j = 0; j < 4; ++j) kf[(g + 1) & 1][j] = lds16(L + RK_OFF + (16 * (2 * (g + 1) + (j >> 1)) + fr) * 144 + (32 * (j & 1) + 8 * fq) * 2);
                }
                SCHED_FENCE();
#pragma unroll
                for (int j = 0; j < 4; ++j) { const int mb = 2 * g + (j >> 1); if ((j & 1) == 0) S[mb] = (f32x4){0.f, 0.f, 0.f, 0.f}; S[mb] = mfma16(kf[g & 1][j], qf[j & 1], S[mb]); }
                SCHED_FENCE();
            }
#pragma unroll
            for (int mb = 0; mb < 8; ++mb)
#pragma unroll
                for (int i = 0; i < 4; ++i) if (16 * mb + 4 * fq + i > 16 * w + fr) S[mb][i] = 0.f;
        }
        f32x4 acc[8];
        {
            bf16x8 rf_[2][4];
#pragma unroll
            for (int j = 0; j < 4; ++j) rf_[0][j] = lds16(L + RRT_OFF + (16 * ((j >> 1) ^ ebase) + fr) * 144 + (32 * (j & 1) + 8 * fq) * 2);
#pragma unroll
            for (int g = 0; g < 4; ++g) {
                if (g < 3) {
#pragma unroll
                    for (int j = 0; j < 4; ++j) rf_[(g + 1) & 1][j] = lds16(L + RRT_OFF + (16 * ((2 * (g + 1) + (j >> 1)) ^ ebase) + fr) * 144 + (32 * (j & 1) + 8 * fq) * 2);
                }
                SCHED_FENCE();
#pragma unroll
                for (int j = 0; j < 4; ++j) { const int eb = 2 * g + (j >> 1); if ((j & 1) == 0) acc[eb] = (f32x4){0.f, 0.f, 0.f, 0.f}; acc[eb] = mfma16(rf_[g & 1][j], qf[j & 1], acc[eb]); }
                SCHED_FENCE();
            }
#pragma unroll
            for (int eb = 0; eb < 8; ++eb) acc[eb] = acc[eb] * g128;
        }
#pragma unroll
        for (int t = 0; t < 4; ++t) Racc[t] = Racc[t] * g128;
        {
            const int tcol = 4 * (fr & 3);
            s16x4 vb[2][8];
#define RV_LOAD(buf, s_, half_) do { const int trow_ = 32 * (s_) + 4 * fq + (fr >> 2); _Pragma("unroll") for (int e_ = 0; e_ < 4; ++e_) { \
                vb[buf][2 * e_] = ldstr(L + RV_OFF + trow_ * 288 + (16 * ((4 * (half_) + e_) ^ ebase) + tcol) * 2); vb[buf][2 * e_ + 1] = ldstr(L + RV_OFF + (trow_ + 16) * 288 + (16 * ((4 * (half_) + e_) ^ ebase) + tcol) * 2); } } while (0)
            RV_LOAD(0, 0, 0);
#pragma unroll
            for (int s = 0; s < 4; ++s) {
                u32x4 pw; pw.x = pk2(S[2 * s][0], S[2 * s][1]); pw.y = pk2(S[2 * s][2], S[2 * s][3]); pw.z = pk2(S[2 * s + 1][0], S[2 * s + 1][1]); pw.w = pk2(S[2 * s + 1][2], S[2 * s + 1][3]);
                const bf16x8 pf = __builtin_bit_cast(bf16x8, pw);
                const int trow = 32 * s + 4 * fq + (fr >> 2);
                const bf16x8 ktf = cat4(ldstr(L + RK_OFF + trow * 144 + (16 * db + tcol) * 2), ldstr(L + RK_OFF + (trow + 16) * 144 + (16 * db + tcol) * 2));
#pragma unroll
                for (int hf = 0; hf < 2; ++hf) {
                    const int bi = 2 * s + hf;
                    if (bi < 7) RV_LOAD((bi + 1) & 1, (bi + 1) >> 1, (bi + 1) & 1);
                    SCHED_FENCE();
#pragma unroll
                    for (int e = 0; e < 4; ++e) { const int eb = 4 * hf + e; const bf16x8 vf = cat4(vb[bi & 1][2 * e], vb[bi & 1][2 * e + 1]);
                        acc[eb] = mfma16(vf, pf, acc[eb]);
                        if (hf == 0) Racc[e] = mfma16(ktf, vf, Racc[e]); }
                    SCHED_FENCE();
                }
            }
#undef RV_LOAD
        }
        const float rowf = exp2f((float)(16 * w + fr - 127) * lg2);
#pragma unroll
        for (int eb = 0; eb < 8; ++eb) acc[eb] = acc[eb] * rowf;
        headnorm_store(acc, nw, gq, L + RSTG_OFF + w * 4352, mix + (row0 + 16 * w) * DM + h * 128, lane, ebase);
    }
}

constexpr int MQ_OFF = 0, MK_OFF = 34816, MV_OFF = 69632, MCT_OFF = 106496, MCW_OFF = 145664, MGC_OFF = 150784, MGS_OFF = 152320, MNW_OFF = 152704;
DI float logsig_f(float x) { return fminf(x, 0.f) - log1pf(__expf(-fabsf(x))); }
DI void mlstm_item(Frame& F, const Args& a, int b, int h, int midx) {
    const lptr L = F.lds; const int w = F.wave;
    const bf16_t* proj = (const bf16_t*)(F.ws + WS_PROJ); bf16_t* mix = (bf16_t*)(F.ws + WS_MIX);
    const float* gates = (const float*)(F.ws + WS_GATES);
    f32x4* garr = (f32x4*)(F.ws + WS_GARR) + (size_t)midx * SEQ;
    LAS float* cw = (LAS float*)(L + MCW_OFF);
    LAS float* gcu = (LAS float*)(L + MGC_OFF); LAS float* gcr = gcu + 128; LAS float* gcd = gcu + 256;
    LAS float* gs_old = (LAS float*)(L + MGS_OFF); LAS float* gs_loc = gs_old + 16; LAS float* gs_rat = gs_old + 32; LAS float* gs_M = gs_old + 48; LAS float* gs_bt = gs_old + 64; LAS float* gs_mp = gs_old + 80;
    LAS float* nw = (LAS float*)(L + MNW_OFF);
    {
        const int lane = lane_id(), tid = w * 64 + lane;
        for (int i = tid; i < 39168 / 16; i += NTHR) *(LAS u32x4*)(L + MCT_OFF + i * 16) = (u32x4){0u, 0u, 0u, 0u};
        if (tid < 128) { *(LAS u32x4*)(L + MV_OFF + tid * 288 + 256) = (u32x4){0x00003F80u, 0u, 0u, 0u}; *(LAS u32x4*)(L + MV_OFF + tid * 288 + 272) = (u32x4){0u, 0u, 0u, 0u};
#pragma unroll
            for (int j = 0; j < 4; ++j) { cw[j * 128 + tid] = a.in[5][j * 1024 + h * 128 + tid]; cw[640 + j * 128 + tid] = a.in[5][j * 1024 + 512 + h * 128 + tid]; }
            cw[512 + tid] = a.in[6][h * 128 + tid]; cw[640 + 512 + tid] = a.in[6][512 + h * 128 + tid]; nw[tid] = a.in[8][h * 128 + tid]; }
        LAS float* tb = (LAS float*)L; LAS float* tg = tb + 2048; LAS float* tpm = tb + 4096;
#pragma unroll
        for (int cc = 0; cc < 2; ++cc) {
            const int c = 2 * w + cc; const float* gp = gates + ((size_t)b * SEQ + c * 128 + 2 * lane) * 8;
            const float ig0 = gp[h], ig1 = gp[8 + h]; const float lf0 = logsig_f(gp[4 + h]), lf1 = logsig_f(gp[12 + h]);
            float incl = lf0 + lf1;
#pragma unroll
            for (int o = 1; o < 64; o <<= 1) { const float t = __shfl_up(incl, o); if (lane >= o) incl += t; }
            const float b1 = incl, b0 = incl - lf1;
            const float g0 = ig0 - b0, g1 = ig1 - b1;
            float pmi = fmaxf(g0, g1);
#pragma unroll
            for (int o = 1; o < 64; o <<= 1) { const float t = __shfl_up(pmi, o); if (lane >= o) pmi = fmaxf(pmi, t); }
            float pme = __shfl_up(pmi, 1); if (lane == 0) pme = -INFINITY;
            const int r = c * 128 + 2 * lane;
            tb[r] = b0; tb[r + 1] = b1; tg[r] = g0; tg[r + 1] = g1; tpm[r] = fmaxf(pme, g0); tpm[r + 1] = pmi;
            if (lane == 63) { gs_M[c] = pmi; gs_bt[c] = incl; }
        }
        __syncthreads();
        if (tid == 0) { float mprev = 0.f;
            for (int c = 0; c < 16; ++c) { const float M = gs_M[c], bt = gs_bt[c]; gs_mp[c] = mprev; const float mloc = bt + M, mnew = fmaxf(bt + mprev, mloc);
                gs_old[c] = __expf(bt + mprev - mnew); gs_loc[c] = __expf(mloc - mnew); gs_rat[c] = __expf(fminf(mprev - M, 80.f)); mprev = mnew; } }
        __syncthreads();
#pragma unroll
        for (int k = 0; k < 4; ++k) { const int r = tid + NTHR * k, c = r >> 7; const float bb = tb[r], M = gs_M[c]; const float mt = bb + fmaxf(tpm[r], gs_mp[c]);
            garr[r] = (f32x4){__expf(tg[r] - M), __expf(bb + M - mt), __expf(-mt), 0.f}; }
        __syncthreads();
    }
    f32x4 C[9];
#pragma unroll
    for (int t = 0; t < 9; ++t) C[t] = (f32x4){0.f, 0.f, 0.f, 0.f};
    u32x4 vv[4], xr[11]; f32x4 ga = {0.f, 0.f, 0.f, 0.f};
#define ML_LOADX(cidx) do { const size_t rown_ = (size_t)b * SEQ + (size_t)(cidx) * 128; const int col_ = 1536 + (w >= 4 ? 512 : 0) + h * 128 + 8 * cgp; \
        _Pragma("unroll") for (int rr = 0; rr < 11; ++rr) { const int lr = 8 * rb8 + rr - 3; const bool ok_ = ((cidx) > 0) || (lr >= 0); \
            xr[rr] = ok_ ? *(const u32x4*)(proj + (size_t)((long)rown_ + lr) * NP1 + col_) : (u32x4){0u, 0u, 0u, 0u}; } } while (0)
#define ML_LOADS(cidx) do { const size_t rown_ = (size_t)b * SEQ + (size_t)(cidx) * 128; \
        _Pragma("unroll") for (int i = 0; i < 4; ++i) { const int p = tid + i * NTHR, r = p >> 4, ch = p & 15; vv[i] = *(const u32x4*)(proj + (rown_ + r) * NP1 + 2560 + h * 128 + ch * 8); } \
        if (tid < 128) ga = garr[(cidx) * 128 + tid]; } while (0)
    { const int tid = w * 64 + lane_id(), cgp = tid & 15, rb8 = (tid & 255) >> 4; ML_LOADS(0); ML_LOADX(0); }
    for (int c = 0; c < 16; ++c) {
        const size_t row0 = (size_t)b * SEQ + c * 128;
        int tid = F.wave * 64 + lane_id(); asm volatile("" : "+v"(tid));
        const int lane = tid & 63, fr = lane & 15, fq = lane >> 4, cgp = tid & 15, rb8 = (tid & 255) >> 4;
        __syncthreads();
        if (c > 0) {
#pragma unroll
            for (int eb = 0; eb < 9; ++eb) { u32x2 pk; pk.x = pk2(C[eb][0], C[eb][1]); pk.y = pk2(C[eb][2], C[eb][3]);
                *(LAS u32x2*)(L + MCT_OFF + (16 * eb + fr) * 272 + (16 * w + 4 * fq) * 2) = pk; }
        }
#pragma unroll
        for (int i = 0; i < 4; ++i) { const int p = tid + i * NTHR, r = p >> 4, ch = p & 15; *(LAS u32x4*)(L + MV_OFF + r * 288 + ch * 16) = vv[i]; }
        if (tid < 128) { gcu[tid] = ga[0]; gcr[tid] = ga[1]; gcd[tid] = ga[2]; }
        {
            const int isk = (w >= 4) ? 1 : 0; f32x2 wv[4][4], bv[4];
#pragma unroll
            for (int j = 0; j < 5; ++j) { const f32x4 w0 = *(const LAS f32x4*)(cw + isk * 640 + j * 128 + 8 * cgp), w1 = *(const LAS f32x4*)(cw + isk * 640 + j * 128 + 8 * cgp + 4);
                if (j < 4) { wv[j][0] = (f32x2){w0[0], w0[1]}; wv[j][1] = (f32x2){w0[2], w0[3]}; wv[j][2] = (f32x2){w1[0], w1[1]}; wv[j][3] = (f32x2){w1[2], w1[3]}; }
                else { bv[0] = (f32x2){w0[0], w0[1]}; bv[1] = (f32x2){w0[2], w0[3]}; bv[2] = (f32x2){w1[0], w1[1]}; bv[3] = (f32x2){w1[2], w1[3]}; } }
            const float osc = isk ? 0.08838834764831845f : 1.f;
            const lptr tile = L + (isk ? MK_OFF : MQ_OFF) + cgp * 16;
            f32x2 xf[11][4];
#pragma unroll
            for (int rr = 0; rr < 11; ++rr)
#pragma unroll
                for (int p = 0; p < 4; ++p) xf[rr][p] = (f32x2){bflo(xr[rr][p]), bfhi(xr[rr][p])};
#pragma unroll
            for (int r = 0; r < 8; ++r) { u32x4 o;
#pragma unroll
                for (int p = 0; p < 4; ++p) { f32x2 acc_ = bv[p];
#pragma unroll
                    for (int j = 0; j < 4; ++j) acc_ = __builtin_elementwise_fma(wv[j][p], xf[r + j][p], acc_);
                    o[p] = pk2(silu_f(acc_[0]) * osc, silu_f(acc_[1]) * osc); }
                *(LAS u32x4*)(tile + (8 * rb8 + r) * 272) = o; }
        }
        __syncthreads();
        { const int cn = c < 15 ? c + 1 : c; ML_LOADS(cn); }
        const size_t grow = row0 + 16 * w + fr;
        u32x4 gq[4];
#pragma unroll
        for (int it = 0; it < 4; ++it) gq[it] = *(const u32x4*)(proj + (row0 + 16 * w + fq + 4 * it) * NP1 + 3072 + h * 128 + 8 * fr);
        bf16x8 qf[4];
#pragma unroll
        for (int ks = 0; ks < 4; ++ks) qf[ks] = lds16(L + MQ_OFF + (16 * w + fr) * 272 + (32 * ks + 8 * fq) * 2);
        const float so = gs_old[c], sl = gs_loc[c], rat = gs_rat[c];
        f32x4 acc[9];
        {
            bf16x8 cf[2][4];
#pragma unroll
            for (int ks = 0; ks < 4; ++ks) cf[0][ks] = lds16(L + MCT_OFF + fr * 272 + (32 * ks + 8 * fq) * 2);
#pragma unroll
            for (int eb = 0; eb < 9; ++eb) {
                if (eb < 8) {
#pragma unroll
                    for (int ks = 0; ks < 4; ++ks) cf[(eb + 1) & 1][ks] = lds16(L + MCT_OFF + (16 * (eb + 1) + fr) * 272 + (32 * ks + 8 * fq) * 2);
                }
                SCHED_FENCE();
                acc[eb] = (f32x4){0.f, 0.f, 0.f, 0.f};
#pragma unroll
                for (int ks = 0; ks < 4; ++ks) acc[eb] = mfma16(cf[eb & 1][ks], qf[ks], acc[eb]);
                SCHED_FENCE();
            }
#pragma unroll
            for (int eb = 0; eb < 9; ++eb) { acc[eb] = acc[eb] * rat; C[eb] = C[eb] * so; }
        }
        {
            const int tcol = 4 * (fr & 3);
            s16x4 vb[2][6];
#define MV_LOAD(buf, s_, g_) do { const int trow_ = 32 * (s_) + 4 * fq + (fr >> 2); _Pragma("unroll") for (int e_ = 0; e_ < 3; ++e_) { \
                vb[buf][2 * e_] = ldstr(L + MV_OFF + trow_ * 288 + (16 * (3 * (g_) + e_) + tcol) * 2); vb[buf][2 * e_ + 1] = ldstr(L + MV_OFF + (trow_ + 16) * 288 + (16 * (3 * (g_) + e_) + tcol) * 2); } } while (0)
#pragma unroll
            for (int hf = 0; hf < 2; ++hf) {
                f32x4 S[4];
                {
                    bf16x8 kf[2][4];
#pragma unroll
                    for (int ks = 0; ks < 4; ++ks) kf[0][ks] = lds16(L + MK_OFF + (64 * hf + fr) * 272 + (32 * ks + 8 * fq) * 2);
#pragma unroll
                    for (int sq = 0; sq < 4; ++sq) {
                        if (sq < 3) {
#pragma unroll
                            for (int ks = 0; ks < 4; ++ks) kf[(sq + 1) & 1][ks] = lds16(L + MK_OFF + (64 * hf + 16 * (sq + 1) + fr) * 272 + (32 * ks + 8 * fq) * 2);
                        } else { MV_LOAD(0, 2 * hf, 0); }
                        SCHED_FENCE();
                        S[sq] = (f32x4){0.f, 0.f, 0.f, 0.f};
#pragma unroll
                        for (int ks = 0; ks < 4; ++ks) S[sq] = mfma16(kf[sq & 1][ks], qf[ks], S[sq]);
                        SCHED_FENCE();
                    }
                }
#pragma unroll
                for (int sq = 0; sq < 4; ++sq) { const int sb = 4 * hf + sq; const f32x4 u4 = *(const LAS f32x4*)(gcu + 16 * sb + 4 * fq);
#pragma unroll
                    for (int i = 0; i < 4; ++i) S[sq][i] = (16 * sb + 4 * fq + i > 16 * w + fr) ? 0.f : S[sq][i] * u4[i]; }
#pragma unroll
                for (int s2 = 0; s2 < 2; ++s2) { const int s = 2 * hf + s2;
                    u32x4 pw; pw.x = pk2(S[2 * s2][0], S[2 * s2][1]); pw.y = pk2(S[2 * s2][2], S[2 * s2][3]); pw.z = pk2(S[2 * s2 + 1][0], S[2 * s2 + 1][1]); pw.w = pk2(S[2 * s2 + 1][2], S[2 * s2 + 1][3]);
                    const bf16x8 pf = __builtin_bit_cast(bf16x8, pw);
                    const int trow = 32 * s + 4 * fq + (fr >> 2);
                    u32x4 kt = __builtin_bit_cast(u32x4, cat4(ldstr(L + MK_OFF + trow * 272 + (16 * w + tcol) * 2), ldstr(L + MK_OFF + (trow + 16) * 272 + (16 * w + tcol) * 2)));
                    const f32x4 ua = *(const LAS f32x4*)(gcu + 32 * s + 4 * fq) * sl, ub = *(const LAS f32x4*)(gcu + 32 * s + 16 + 4 * fq) * sl;
                    kt.x = pk2(bflo(kt.x) * ua[0], bfhi(kt.x) * ua[1]); kt.y = pk2(bflo(kt.y) * ua[2], bfhi(kt.y) * ua[3]); kt.z = pk2(bflo(kt.z) * ub[0], bfhi(kt.z) * ub[1]); kt.w = pk2(bflo(kt.w) * ub[2], bfhi(kt.w) * ub[3]);
                    const bf16x8 ktf = __builtin_bit_cast(bf16x8, kt);
#pragma unroll
                    for (int g = 0; g < 3; ++g) { const int bi = 3 * s2 + g;
                        if (bi < 5) MV_LOAD((bi + 1) & 1, 2 * hf + (bi + 1) / 3, (bi + 1) % 3);
                        SCHED_FENCE();
#pragma unroll
                        for (int e = 0; e < 3; ++e) { const int eb = 3 * g + e; const bf16x8 vf = cat4(vb[bi & 1][2 * e], vb[bi & 1][2 * e + 1]);
                            acc[eb] = mfma16(vf, pf, acc[eb]);
                            C[eb] = mfma16(ktf, vf, C[eb]); }
                        SCHED_FENCE();
                    }
                }
            }
#undef MV_LOAD
        }
        { const int cn = c < 15 ? c + 1 : c; ML_LOADX(cn); }
        {
            const int t = 16 * w + fr; const float rf = gcr[t], dc = gcd[t];
            float den = rf * acc[8][0]; den = __shfl(den, fr);
            const float sc = rf / fmaxf(fabsf(den), dc);
            f32x4 hv[8];
#pragma unroll
            for (int eb = 0; eb < 8; ++eb) hv[eb] = acc[eb] * sc;
            headnorm_store(hv, nw, gq, L + MQ_OFF + 16 * w * 272, mix + (row0 + 16 * w) * DM + 512 + h * 128, lane, 0);
        }
    }
#undef ML_LOADS
#undef ML_LOADX
}
constexpr int MW_SPLIT = 24576;
struct MwItem { const float* W; bf16_t* WT; const float* ks; int ldn, K, k0, n0, mode; };
DI MwItem mw_decode(const Args& a, unsigned char* ws, int it) {
    constexpr int I_GU = 32 * 16 * 16;
    MwItem m; const int sec = it / I_GU, r = it - sec * I_GU, e = r >> 8, q = r & 255;
    if (sec < 2) { m.W = a.in[20 + sec] + (size_t)e * DM * DEXP; m.WT = (bf16_t*)(ws + WS_W1 + (size_t)e * 1024 * DM); m.ks = a.in[15]; m.ldn = DEXP; m.K = DM; m.k0 = 64 * (q >> 4); m.n0 = 32 * (q & 15); }
    else { m.W = a.in[22] + (size_t)e * DEXP * DM; m.WT = (bf16_t*)(ws + WS_W2 + (size_t)e * DM * DEXP); m.ks = nullptr; m.ldn = DM; m.K = DEXP; m.k0 = 64 * (q >> 5); m.n0 = 32 * (q & 31); }
    m.mode = sec; return m;
}
DI void mw_load(const MwItem& m, int lane, f32x4 (&v)[8], float (&ksc)[8]) {
    const int r8 = lane >> 3, c4 = (lane & 7) * 4;
#pragma unroll
    for (int i = 0; i < 8; ++i) { v[i] = *(const f32x4*)(m.W + (size_t)(m.k0 + r8 + 8 * i) * m.ldn + m.n0 + c4); ksc[i] = m.ks ? m.ks[m.k0 + r8 + 8 * i] : 1.f; }
}
DI void mw_store(const MwItem& m, int lane, LAS float* scr, const f32x4 (&v)[8], const float (&ksc)[8]) {
    const int r8 = lane >> 3, c4 = (lane & 7) * 4;
#pragma unroll
    for (int i = 0; i < 8; ++i) { LAS float* d = scr + (r8 + 8 * i) * 33 + c4; d[0] = v[i][0] * ksc[i]; d[1] = v[i][1] * ksc[i]; d[2] = v[i][2] * ksc[i]; d[3] = v[i][3] * ksc[i]; }
    asm volatile("s_waitcnt lgkmcnt(0)" ::: "memory");
    const int c = lane & 7;
#pragma unroll
    for (int j = 0; j < 4; ++j) { const int nl = (lane >> 3) + 8 * j, n = m.n0 + nl; const LAS float* s = scr + (8 * c) * 33 + nl;
        const long orow = (m.mode < 2) ? (long)(n >> 7) * 256 + m.mode * 128 + (n & 127) : n;
        const float sc = (m.mode < 2) ? 32.f : 16.f;
        u32x2 o; o.x = pk4_fp8(s[0 * 33] * sc, s[1 * 33] * sc, s[2 * 33] * sc, s[3 * 33] * sc); o.y = pk4_fp8(s[4 * 33] * sc, s[5 * 33] * sc, s[6 * 33] * sc, s[7 * 33] * sc);
        *(u32x2*)((unsigned char*)m.WT + (size_t)orow * m.K + m.k0 + 8 * c) = o; }
    asm volatile("s_waitcnt lgkmcnt(0)" ::: "memory");
}
DI void moe_weight_items(Frame& F, const Args& a, int wi, int nw, int it_lo, int it_hi) {
    LAS float* scr = (LAS float*)(F.lds + F.wave * 16384);
    const int lane = lane_id_v(); unsigned char* ws = F.ws;
    const int NIT = it_hi; int it = it_lo + wi;
    if (it >= NIT) return;
    const float* gm = a.in[15];
    f32x4 vA[8], vB[8]; float kA[8], kB[8];
#define MW_LOAD(S, m_) do { const int r8_ = lane >> 3, c4_ = (lane & 7) * 4; \
        _Pragma("unroll") for (int i = 0; i < 8; ++i) asm volatile("global_load_dwordx4 %0, %1, off" : "=v"(v##S[i]) : "v"((m_).W + (size_t)((m_).k0 + r8_ + 8 * i) * (m_).ldn + (m_).n0 + c4_) : "memory"); \
        _Pragma("unroll") for (int i = 0; i < 8; ++i) asm volatile("global_load_dword %0, %1, off" : "=v"(k##S[i]) : "v"(gm + (m_).k0 + r8_ + 8 * i) : "memory"); } while (0)
#define MW_WAIT(n_, S) asm volatile("s_waitcnt vmcnt(" #n_ ")" : "+v"(v##S[0]), "+v"(v##S[1]), "+v"(v##S[2]), "+v"(v##S[3]), "+v"(v##S[4]), "+v"(v##S[5]), "+v"(v##S[6]), "+v"(v##S[7]), \
        "+v"(k##S[0]), "+v"(k##S[1]), "+v"(k##S[2]), "+v"(k##S[3]), "+v"(k##S[4]), "+v"(k##S[5]), "+v"(k##S[6]), "+v"(k##S[7]) :: "memory")
#define MW_STORE(S, m_) do { float ks_[8]; _Pragma("unroll") for (int i = 0; i < 8; ++i) ks_[i] = ((m_).mode == 2) ? 1.f : k##S[i]; mw_store((m_), lane, scr, v##S, ks_); } while (0)
    MwItem cur = mw_decode(a, ws, it);
    MW_LOAD(A, cur);
    bool first = true;
    for (;;) {
        { const int itn = (it + nw < NIT) ? it + nw : it; const MwItem nxt = mw_decode(a, ws, itn);
          MW_LOAD(B, nxt);
          if (first) MW_WAIT(16, A); else MW_WAIT(18, A);
          first = false;
          MW_STORE(A, cur); it += nw; if (it >= NIT) break; cur = nxt; }
        { const int itn = (it + nw < NIT) ? it + nw : it; const MwItem nxt = mw_decode(a, ws, itn);
          MW_LOAD(A, nxt);
          MW_WAIT(18, B);
          MW_STORE(B, cur); it += nw; if (it >= NIT) break; cur = nxt; }
    }
    asm volatile("s_waitcnt vmcnt(0)" ::: "memory");
#undef MW_LOAD
#undef MW_WAIT
#undef MW_STORE
}
DI void p2_mixer(Frame& F, const Args& a) {
    const int nret = (F.G + 1) / 2;
    for (int item = F.vcu; item < 256; item += F.G) {
        const int b = item >> 3, h = (item >> 1) & 3;
        if (item & 1) mlstm_item(F, a, b, h, item >> 1); else ret_item(F, a, b, h);
        __syncthreads();
    }
    if ((F.vcu & 1) == 0) {
        const int rc = F.vcu >> 1;
        SchedKV S; S.first = rc; S.step = nret; S.A = (const char*)(F.ws + WS_MEMN); S.B = (const char*)(F.ws + WS_WKV);
        EpiKV8 E{F.ws + WS_KV};
        pg8::gemm_phase<EpiKV8, SchedKV, false, true>(F.lds, DM, S, E, F.wave, 122);
        __syncthreads();
        moe_weight_items(F, a, rc * NWAVES + F.wave, nret * NWAVES, 0, MW_SPLIT);
    }
}

struct EpiP4 {
    static constexpr int NPRE = 0;
    const float* ssq; unsigned char* q;
    DI void operator()(const f32x4 (&acc)[2][2][4][2], const pg8::Unit& u, int wr, int wc, int fr, int fq) const {
        asm volatile("" : "+v"(fr), "+v"(fq));
        const int row0 = u.pm * 256 + wr * 64 + fr, col0 = u.pn * 256 + wc * 32 + 8 * fq;
        f32x4 sp[2][4];
#pragma unroll
        for (int ai = 0; ai < 2; ++ai)
#pragma unroll
            for (int m = 0; m < 4; ++m) sp[ai][m] = *((const f32x4*)(ssq + (size_t)(row0 + ai * 128 + m * 16) * 16) + fq);
        SCHED_FENCE();
        const int odd = fq & 1;
#pragma unroll
        for (int ai = 0; ai < 2; ++ai) {
            u32x2 wq[4][2];
#pragma unroll
            for (int m = 0; m < 4; ++m) {
                float tot = (sp[ai][m][0] + sp[ai][m][1]) + (sp[ai][m][2] + sp[ai][m][3]); tot += __shfl_xor(tot, 16); tot += __shfl_xor(tot, 32);
                const float rstd = rsqrtf(tot * (1.f / DM) + EPS);
#pragma unroll
                for (int bj = 0; bj < 2; ++bj) { const f32x4 v0 = acc[ai][bj][m][0] * rstd, v1 = acc[ai][bj][m][1] * rstd;
                    wq[m][bj].x = pk4_fp8(v0[0], v0[1], v0[2], v0[3]); wq[m][bj].y = pk4_fp8(v1[0], v1[1], v1[2], v1[3]); }
            }
#pragma unroll
            for (int mp = 0; mp < 2; ++mp)
#pragma unroll
                for (int bj = 0; bj < 2; ++bj) *(u32x4*)(q + (size_t)(row0 + ai * 128 + (2 * mp + odd) * 16) * DM + col0 - 8 * odd + bj * 128) = pair16(wq[2 * mp][bj], wq[2 * mp + 1][bj]);
        }
    }
};
struct EpiP6 {
    static constexpr int NPRE = 0;
    const bf16_t* x1b; bf16_t* x2b; unsigned char* xq8;
    DI void operator()(const f32x4 (&acc)[2][2][4][2], const pg8::Unit& u, int wr, int wc, int fr, int fq) const {
        asm volatile("" : "+v"(fr), "+v"(fq));
        const int row0 = u.pm * 256 + wr * 64 + fr, col0 = u.pn * 256 + wc * 32 + 8 * fq;
        u32x4 rv[2][4][2];
#pragma unroll
        for (int ai = 0; ai < 2; ++ai)
#pragma unroll
            for (int m = 0; m < 4; ++m)
#pragma unroll
                for (int bj = 0; bj < 2; ++bj) rv[ai][m][bj] = *(const u32x4*)(x1b + (size_t)(row0 + ai * 128 + m * 16) * DM + col0 + bj * 128);
        SCHED_FENCE();
        const int odd = fq & 1;
#pragma unroll
        for (int ai = 0; ai < 2; ++ai) {
            u32x2 w8s[4][2];
#pragma unroll
            for (int m = 0; m < 4; ++m) {
                const int grow = row0 + ai * 128 + m * 16;
#pragma unroll
                for (int bj = 0; bj < 2; ++bj) { const size_t off = (size_t)grow * DM + col0 + bj * 128; const u32x4 r = rv[ai][m][bj];
                    const f32x4 v0 = acc[ai][bj][m][0], v1 = acc[ai][bj][m][1];
                    u32x4 w; w.x = pk2(v0[0] + bflo(r.x), v0[1] + bfhi(r.x)); w.y = pk2(v0[2] + bflo(r.y), v0[3] + bfhi(r.y)); w.z = pk2(v1[0] + bflo(r.z), v1[1] + bfhi(r.z)); w.w = pk2(v1[2] + bflo(r.w), v1[3] + bfhi(r.w));
                    *(u32x4*)(x2b + off) = w;
                    w8s[m][bj].x = pk4_fp8(v0[0] + bflo(r.x), v0[1] + bfhi(r.x), v0[2] + bflo(r.y), v0[3] + bfhi(r.y)); w8s[m][bj].y = pk4_fp8(v1[0] + bflo(r.z), v1[1] + bfhi(r.z), v1[2] + bflo(r.w), v1[3] + bfhi(r.w)); }
            }
#pragma unroll
            for (int mp = 0; mp < 2; ++mp)
#pragma unroll
                for (int bj = 0; bj < 2; ++bj) *(u32x4*)(xq8 + (size_t)(row0 + ai * 128 + (2 * mp + odd) * 16) * DM + col0 - 8 * odd + bj * 128) = pair16(w8s[2 * mp][bj], w8s[2 * mp + 1][bj]);
        }
    }
};

typedef float f32x16 __attribute__((ext_vector_type(16)));
DI f32x16 mfma32(bf16x8 a, bf16x8 b, f32x16 c) { return __builtin_amdgcn_mfma_f32_32x32x16_bf16(a, b, c, 0, 0, 0); }
constexpr int ARING = 36864;
template <int STRIDE, int ROWB, int NROWS, bool KPERM>
DI void attn_dma5(lptr L, int slot, const bf16_t* src, int w) {
    const int l16 = 16 * lane_id_v();
    const int q0 = l16 / STRIDE, r0 = l16 - q0 * STRIDE;
    constexpr int NCH = NROWS * STRIDE / 1024;
#pragma unroll
    for (int i = 0; i < 5; ++i) {
        int k = w + 8 * i; k = k < NCH ? k : NCH - 1;
        const int Q = (1024 * k) / STRIDE, R = 1024 * k - Q * STRIDE;
        int cb = R + r0, row = Q + q0; if (cb >= STRIDE) { cb -= STRIDE; row += 1; }
        if (KPERM) row = (row & ~12) | ((row & 4) << 1) | ((row & 8) >> 1);
        const unsigned off = (cb < ROWB) ? (unsigned)(row * 256 + (cb >> 1)) : 0u;
        __builtin_amdgcn_global_load_lds((const unsigned*)(src + off), (LAS unsigned*)(L + slot * ARING + 1024 * k), 16, 0, 0);
    }
}
DI bf16x8 fp8x8_to_bf16(u32x2 r) {
    const f32x2 a = __builtin_amdgcn_cvt_pk_f32_fp8((int)r.x, false), b = __builtin_amdgcn_cvt_pk_f32_fp8((int)r.x, true), c = __builtin_amdgcn_cvt_pk_f32_fp8((int)r.y, false), d = __builtin_amdgcn_cvt_pk_f32_fp8((int)r.y, true);
    u32x4 w; w.x = pk2(a[0], a[1]); w.y = pk2(b[0], b[1]); w.z = pk2(c[0], c[1]); w.w = pk2(d[0], d[1]);
    return __builtin_bit_cast(bf16x8, w);
}
template <int DBG> DI void attn_phase(Frame& F) {
    const lptr L = F.lds; const int w = F.wave;
    const unsigned char* q8 = F.ws + WS_Q; const bf16_t* kv = (const bf16_t*)(F.ws + WS_KV); unsigned char* o8 = F.ws + WS_O;
    constexpr int NU = 1024;
    constexpr bool d_nodma = DBG & 1;
    const lptr stg = L + w * 8704;
#define AT_ISSUE(m_) do { if (d_nodma) break; const bf16_t* base_ = kv + ((size_t)bh << 16); \
        if ((m_) < 4) attn_dma5<528, 512, 64, true>(L, ((m_) + 2) & 3, base_ + 64 * (m_) * 256, w); else attn_dma5<144, 128, 256, false>(L, ((m_) + 2) & 3, base_ + ((size_t)NB * 4 << 16) + 64 * ((m_) - 4), w); } while (0)
#define AT_WAIT(m_) do { if ((m_) <= 5) asm volatile("s_waitcnt vmcnt(10)" ::: "memory"); else if ((m_) == 6) asm volatile("s_waitcnt vmcnt(5)" ::: "memory"); else asm volatile("s_waitcnt vmcnt(8)" ::: "memory"); \
        __builtin_amdgcn_s_barrier(); asm volatile("" ::: "memory"); } while (0)
#define AT_QROWS(u_) do { const int u__ = (u_), bh__ = u__ >> 3; const int l__ = lane_id_v(); \
        const unsigned char* src__ = q8 + ((size_t)(bh__ >> 2) * SEQ + (u__ & 7) * 256 + 32 * w + (l__ >> 4)) * DM + (bh__ & 3) * 256 + 16 * (l__ & 15); \
        _Pragma("unroll") for (int it = 0; it < 8; ++it) asm volatile("global_load_dwordx4 %0, %1, off" : "=v"(qt_[it]) : "v"(src__ + (size_t)(4 * it) * DM) : "memory"); } while (0)
    u32x4 qt_[8];
    if (F.vcu < NU) AT_QROWS(F.vcu);
    for (int u = F.vcu; u < NU; u += F.G) {
        const int bh = u >> 3, qt = u & 7, b = bh >> 2, h = bh & 3;
        const int ln_ = lane_id_v();
        const int lr = ln_ & 31, lh = ln_ >> 5;
        const size_t row0 = (size_t)b * SEQ + qt * 256 + 32 * w;
        AT_ISSUE(0); AT_ISSUE(1);
        if (u == F.vcu) asm volatile("s_waitcnt vmcnt(10)" ::: "memory"); else asm volatile("s_waitcnt vmcnt(18)" ::: "memory");
#pragma unroll
        for (int it = 0; it < 8; ++it) *(LAS u32x4*)(stg + (4 * it + (ln_ >> 4)) * 272 + 16 * (ln_ & 15)) = qt_[it];
        bf16x8 qf[16];
#pragma unroll
        for (int ks = 0; ks < 16; ++ks) qf[ks] = fp8x8_to_bf16(*(const LAS u32x2*)(stg + lr * 272 + 16 * ks + 8 * lh));
        asm volatile("s_waitcnt lgkmcnt(0)" ::: "memory");
        __builtin_amdgcn_s_barrier(); asm volatile("" ::: "memory");
        AT_ISSUE(2);
        f32x16 S[8];
        bf16x8 kfA[4], kfB[4];
#define AT_LDS16(d_, a_) asm volatile("ds_read_b128 %0, %1" : "=v"(d_) : "v"(a_) : "memory")
#define AT_LWAIT(n_, f_) asm volatile("s_waitcnt lgkmcnt(" #n_ ")" : "+v"(f_[0]), "+v"(f_[1]), "+v"(f_[2]), "+v"(f_[3]) :: "memory")
#define AT_KREAD(dst_, i_) do { const unsigned kb_ = (unsigned)(size_t)L + ((((i_) >> 3) + 2) & 3) * ARING + lr * 528 + lh * 16 + (((i_) & 7) >> 2) * 32 * 528 + 128 * ((i_) & 3); \
        _Pragma("unroll") for (int jj = 0; jj < 4; ++jj) AT_LDS16(dst_[jj], kb_ + 32 * jj); } while (0)
#define AT_KMMA(src_, i_) do { const int blk_ = 2 * ((i_) >> 3) + (((i_) & 7) >> 2); \
        if (((i_) & 3) == 0) { _Pragma("unroll") for (int i = 0; i < 16; ++i) S[blk_][i] = 0.f; } \
        _Pragma("unroll") for (int jj = 0; jj < 4; ++jj) S[blk_] = mfma32(src_[jj], qf[4 * ((i_) & 3) + jj], S[blk_]); } while (0)
#define AT_KNEXT(dst_, cur_, i_) do { if ((i_) < 32) { if (((i_) & 7) == 0) { AT_LWAIT(0, cur_); AT_WAIT((i_) >> 3); AT_ISSUE(((i_) >> 3) + 3); } AT_KREAD(dst_, (i_)); AT_LWAIT(4, cur_); } else AT_LWAIT(0, cur_); } while (0)
        AT_WAIT(0); AT_ISSUE(3);
        AT_KREAD(kfA, 0);
#pragma unroll
        for (int i2 = 0; i2 < 32; i2 += 2) {
            AT_KNEXT(kfB, kfA, i2 + 1); SCHED_FENCE(); AT_KMMA(kfA, i2); SCHED_FENCE();
            AT_KNEXT(kfA, kfB, i2 + 2); SCHED_FENCE(); AT_KMMA(kfB, i2 + 1); SCHED_FENCE();
        }
        bf16x8 pf[8][2]; float inv;
        {
            float mx = -INFINITY;
#pragma unroll
            for (int blk = 0; blk < 8; ++blk)
#pragma unroll
                for (int i = 0; i < 16; i += 2) mx = fmaxf(mx, fmaxf(S[blk][i], S[blk][i + 1]));
            { auto rr = __builtin_amdgcn_permlane32_swap(__float_as_uint(mx), __float_as_uint(mx), false, false); mx = fmaxf(__uint_as_float(rr[0]), __uint_as_float(rr[1])); }
            float sum = 0.f;
#pragma unroll
            for (int blk = 0; blk < 8; ++blk)
#pragma unroll
                for (int s_ = 0; s_ < 2; ++s_) { float p[8];
#pragma unroll
                    for (int i = 0; i < 8; ++i) p[i] = __builtin_amdgcn_exp2f(S[blk][8 * s_ + i] - mx);
                    sum += ((p[0] + p[1]) + (p[2] + p[3])) + ((p[4] + p[5]) + (p[6] + p[7]));
                    u32x4 pw; pw.x = pk2(p[0], p[1]); pw.y = pk2(p[2], p[3]); pw.z = pk2(p[4], p[5]); pw.w = pk2(p[6], p[7]);
                    pf[blk][s_] = __builtin_bit_cast(bf16x8, pw); }
            { auto rr = __builtin_amdgcn_permlane32_swap(__float_as_uint(sum), __float_as_uint(sum), false, false); sum = __uint_as_float(rr[0]) + __uint_as_float(rr[1]); }
            inv = __builtin_amdgcn_rcpf(sum);
        }
        f32x16 O[8];
#pragma unroll
        for (int eb = 0; eb < 8; ++eb)
#pragma unroll
            for (int i = 0; i < 16; ++i) O[eb][i] = 0.f;
        {
            bf16x8 vfA[4], vfB[4];
#define AT_VREAD(dst_, i_) do { const unsigned vb_ = (unsigned)(size_t)L + ((((i_) >> 3) + 2) & 3) * ARING + lr * 144 + lh * 16 + ((i_) & 7) * 32 * 144; \
        _Pragma("unroll") for (int kk = 0; kk < 4; ++kk) AT_LDS16(dst_[kk], vb_ + 32 * kk); } while (0)
#define AT_VMMA(src_, i_) do { _Pragma("unroll") for (int kk = 0; kk < 4; ++kk) O[(i_) & 7] = mfma32(src_[kk], pf[2 * ((i_) >> 3) + (kk >> 1)][kk & 1], O[(i_) & 7]); } while (0)
#define AT_VNEXT(dst_, cur_, i_) do { if ((i_) < 32) { if (((i_) & 7) == 0) { AT_LWAIT(0, cur_); AT_WAIT(4 + ((i_) >> 3)); \
        if (((i_) >> 3) == 2) { const int un = u + F.G; AT_QROWS(un < NU ? un : u); } }     \
        AT_VREAD(dst_, (i_)); AT_LWAIT(4, cur_); } else AT_LWAIT(0, cur_); } while (0)
            AT_WAIT(4); AT_ISSUE(7);
            AT_VREAD(vfA, 0);
#pragma unroll
            for (int i2 = 0; i2 < 32; i2 += 2) {
                AT_VNEXT(vfB, vfA, i2 + 1); SCHED_FENCE(); AT_VMMA(vfA, i2); SCHED_FENCE();
                AT_VNEXT(vfA, vfB, i2 + 2); SCHED_FENCE(); AT_VMMA(vfB, i2 + 1); SCHED_FENCE();
            }
        }
        __builtin_amdgcn_s_barrier(); asm volatile("" ::: "memory");
        {
            const int ln2 = lane_id_v(); const int r2 = ln2 & 31, h2 = ln2 >> 5; const float sc16 = inv * 16.f;
#pragma unroll
            for (int eb = 0; eb < 8; ++eb)
#pragma unroll
                for (int g = 0; g < 4; ++g) *(LAS unsigned*)(stg + r2 * 272 + 32 * eb + 8 * g + 4 * h2) = pk4_fp8(O[eb][4 * g] * sc16, O[eb][4 * g + 1] * sc16, O[eb][4 * g + 2] * sc16, O[eb][4 * g + 3] * sc16);
            asm volatile("s_waitcnt lgkmcnt(0)" ::: "memory");
#pragma unroll
            for (int it = 0; it < 8; ++it) { const int rr = 4 * it + (ln2 >> 4), ch = ln2 & 15; const u32x4 v = *(const LAS u32x4*)(stg + rr * 272 + 16 * ch);
                *(u32x4*)(o8 + (row0 + rr) * DM + h * 256 + 16 * ch) = v; }
            asm volatile("s_waitcnt lgkmcnt(0)" ::: "memory");
        }
    }
    asm volatile("s_waitcnt vmcnt(0)" ::: "memory");
    __syncthreads();
#undef AT_ISSUE
#undef AT_WAIT
#undef AT_QROWS
#undef AT_KREAD
#undef AT_LDS16
#undef AT_LWAIT
#undef AT_KMMA
#undef AT_KNEXT
#undef AT_VREAD
#undef AT_VMMA
#undef AT_VNEXT
}

typedef unsigned u32x8 __attribute__((ext_vector_type(8)));
DI void mfma8_32(f32x16& acc, const u32x8& a, const u32x8& b, int sa, int sb) {
    asm volatile("s_nop 1\n\tv_mfma_scale_f32_32x32x64_f8f6f4 %0, %1, %2, %0, %3, %4 op_sel_hi:[0,0,0]" : "+v"(acc) : "v"(a), "v"(b), "v"(sa), "v"(sb));
}
DI u32x8 lds32(lptr p) { return __builtin_shufflevector(*(const LAS u32x4*)p, *(const LAS u32x4*)(p + 16), 0, 1, 2, 3, 4, 5, 6, 7); }
template <bool KPERM>
DI void attn8_img_dma(lptr dst, const unsigned char* src, int w) {
    const int l16 = 16 * lane_id_v(); const int q0 = l16 / 272, r0 = l16 - q0 * 272;
#pragma unroll
    for (int i = 0; i < 9; ++i) {
        int k = w + 8 * i; k = k < 68 ? k : 67;
        const int Q = (1024 * k) / 272, R = 1024 * k - Q * 272;
        int cb = R + r0, row = Q + q0; if (cb >= 272) { cb -= 272; row += 1; }
        if (KPERM) row = (row & ~63) | (((row >> 2) & 1) << 5) | (((row >> 5) & 1) << 4) | (((row >> 3) & 3) << 2) | (row & 3);
        const unsigned off = (cb < 256) ? (unsigned)(row * 256 + cb) : 0u;
        __builtin_amdgcn_global_load_lds((const unsigned*)(src + off), (LAS unsigned*)(dst + 1024 * k), 16, 0, 0);
    }
}
DI void attn8_phase(Frame& F) {
    const lptr L = F.lds; const int w = F.wave;
    const unsigned char* q8 = F.ws + WS_Q; const unsigned char* kv8 = F.ws + WS_KV; unsigned char* o8 = F.ws + WS_O;
    constexpr int VIMG = 69632, STG = 139264;
    const lptr stg = L + STG + w * 2944;
    const int SK = 127, SQ = 121, SV = 127, SP = 119;
    u32x4 qt_[8];
#define A8_QROWS(b_, h_, qt__) do { const int l__ = lane_id_v(); \
        const unsigned char* src__ = q8 + ((size_t)(b_) * SEQ + (qt__) * 256 + 32 * w + (l__ >> 4)) * DM + (h_) * 256 + 16 * (l__ & 15); \
        _Pragma("unroll") for (int it = 0; it < 8; ++it) asm volatile("global_load_dwordx4 %0, %1, off" : "=v"(qt_[it]) : "v"(src__ + (size_t)(4 * it) * DM) : "memory"); } while (0)
    for (int p = F.vcu; p < 256; p += F.G) {
        const int bh = p >> 1, b = bh >> 2, h = bh & 3, qt0 = 4 * (p & 1);
        __syncthreads();
        A8_QROWS(b, h, qt0);
        attn8_img_dma<true>(L, kv8 + ((size_t)bh << 16), w);
        attn8_img_dma<false>(L + VIMG, kv8 + ((size_t)(NB * 4 + bh) << 16), w);
        __builtin_amdgcn_s_waitcnt(0);
        __builtin_amdgcn_s_barrier(); asm volatile("" ::: "memory");
#pragma unroll 1
        for (int ui = 0; ui < 4; ++ui) {
            const int ln_ = lane_id_v();
            const int lr = ln_ & 31, lh = ln_ >> 5, c16 = ln_ & 15, rs = ln_ >> 4;
            const size_t row0 = (size_t)b * SEQ + (qt0 + ui) * 256 + 32 * w;
            if (ui > 0) asm volatile("s_waitcnt vmcnt(8)" ::: "memory");
            u32x8 qf[4];
#pragma unroll
            for (int ks = 0; ks < 4; ++ks) {
                if ((c16 >> 2) == ks) {
#pragma unroll
                    for (int it = 0; it < 8; ++it) *(LAS u32x4*)(stg + (4 * it + rs) * 80 + 16 * (c16 & 3)) = qt_[it];
                }
                asm volatile("" ::: "memory");
                qf[ks] = lds32(stg + lr * 80 + 32 * lh);
                asm volatile("" ::: "memory");
            }
            asm volatile("s_waitcnt lgkmcnt(0)" ::: "memory");
            { const int un = ui + 1 < 4 ? ui + 1 : ui; A8_QROWS(b, h, qt0 + un); }
            f32x16 S[8];
            {
                const lptr kb = L + lr * 272 + 32 * lh;
                u32x8 kfA[2], kfB[2];
#define A8_KREAD(d_, i_) do { d_[0] = lds32(kb + ((i_) >> 1) * 32 * 272 + 128 * ((i_) & 1)); d_[1] = lds32(kb + ((i_) >> 1) * 32 * 272 + 128 * ((i_) & 1) + 64); } while (0)
#define A8_KMMA(s_, i_) do { if (((i_) & 1) == 0) { _Pragma("unroll") for (int i = 0; i < 16; ++i) S[(i_) >> 1][i] = 0.f; } \
        mfma8_32(S[(i_) >> 1], s_[0], qf[2 * ((i_) & 1)], SK, SQ); mfma8_32(S[(i_) >> 1], s_[1], qf[2 * ((i_) & 1) + 1], SK, SQ); } while (0)
                A8_KREAD(kfA, 0);
#pragma unroll
                for (int i2 = 0; i2 < 16; i2 += 2) {
                    A8_KREAD(kfB, i2 + 1); SCHED_FENCE(); A8_KMMA(kfA, i2); SCHED_FENCE();
                    if (i2 + 2 < 16) A8_KREAD(kfA, i2 + 2);
                    SCHED_FENCE(); A8_KMMA(kfB, i2 + 1); SCHED_FENCE();
                }
#undef A8_KREAD
#undef A8_KMMA
            }
            asm volatile("s_nop 15\n\ts_nop 15\n\ts_nop 15" : "+v"(S[0]), "+v"(S[1]), "+v"(S[2]), "+v"(S[3]), "+v"(S[4]), "+v"(S[5]), "+v"(S[6]), "+v"(S[7]));
            u32x8 pf[4]; float inv;
            {
                float mx = -INFINITY;
#pragma unroll
                for (int blk = 0; blk < 8; ++blk)
#pragma unroll
                    for (int i = 0; i < 16; i += 2) mx = fmaxf(mx, fmaxf(S[blk][i], S[blk][i + 1]));
                { auto rr = __builtin_amdgcn_permlane32_swap(__float_as_uint(mx), __float_as_uint(mx), false, false); mx = fmaxf(__uint_as_float(rr[0]), __uint_as_float(rr[1])); }
                float sum = 0.f; const float mx8 = mx - 8.f;
#pragma unroll
                for (int blk = 0; blk < 8; ++blk)
#pragma unroll
                    for (int g = 0; g < 4; ++g) { const float p0 = __builtin_amdgcn_exp2f(S[blk][4 * g] - mx8), p1 = __builtin_amdgcn_exp2f(S[blk][4 * g + 1] - mx8), p2 = __builtin_amdgcn_exp2f(S[blk][4 * g + 2] - mx8), p3 = __builtin_amdgcn_exp2f(S[blk][4 * g + 3] - mx8);
                        sum += (p0 + p1) + (p2 + p3);
                        int w_ = 0; w_ = __builtin_amdgcn_cvt_pk_fp8_f32(p0, p1, w_, false); w_ = __builtin_amdgcn_cvt_pk_fp8_f32(p2, p3, w_, true);
                        pf[blk >> 1][4 * (blk & 1) + g] = (unsigned)w_; }
                { auto rr = __builtin_amdgcn_permlane32_swap(__float_as_uint(sum), __float_as_uint(sum), false, false); sum = __uint_as_float(rr[0]) + __uint_as_float(rr[1]); }
                inv = 256.f * __builtin_amdgcn_rcpf(sum);
            }
            f32x16 O[8];
#pragma unroll
            for (int eb = 0; eb < 8; ++eb)
#pragma unroll
                for (int i = 0; i < 16; ++i) O[eb][i] = 0.f;
            {
                const lptr vb = L + VIMG + lr * 272 + 32 * lh;
                u32x8 vfA[2], vfB[2];
#define A8_VREAD(d_, i_) do { d_[0] = lds32(vb + (2 * ((i_) & 3)) * 32 * 272 + 64 * ((i_) >> 2)); d_[1] = lds32(vb + (2 * ((i_) & 3) + 1) * 32 * 272 + 64 * ((i_) >> 2)); } while (0)
#define A8_VMMA(s_, i_) do { mfma8_32(O[2 * ((i_) & 3)], s_[0], pf[(i_) >> 2], SV, SP); mfma8_32(O[2 * ((i_) & 3) + 1], s_[1], pf[(i_) >> 2], SV, SP); } while (0)
                A8_VREAD(vfA, 0);
#pragma unroll
                for (int i2 = 0; i2 < 16; i2 += 2) {
                    A8_VREAD(vfB, i2 + 1); SCHED_FENCE(); A8_VMMA(vfA, i2); SCHED_FENCE();
                    if (i2 + 2 < 16) A8_VREAD(vfA, i2 + 2);
                    SCHED_FENCE(); A8_VMMA(vfB, i2 + 1); SCHED_FENCE();
                }
#undef A8_VREAD
#undef A8_VMMA
            }
            asm volatile("s_nop 15\n\ts_nop 15\n\ts_nop 15" : "+v"(O[0]), "+v"(O[1]), "+v"(O[2]), "+v"(O[3]), "+v"(O[4]), "+v"(O[5]), "+v"(O[6]), "+v"(O[7]));
            {
                const float sc16 = inv * 16.f; u32x4 ot[8];
#pragma unroll
                for (int it = 0; it < 8; ++it) ot[it] = (u32x4){0u, 0u, 0u, 0u};
#pragma unroll
                for (int ps = 0; ps < 4; ++ps) {
#pragma unroll
                    for (int e2 = 0; e2 < 2; ++e2)
#pragma unroll
                        for (int g = 0; g < 4; ++g) { const f32x16& o = O[2 * ps + e2];
                            *(LAS unsigned*)(stg + lr * 80 + 32 * e2 + 8 * g + 4 * lh) = pk4_fp8(o[4 * g] * sc16, o[4 * g + 1] * sc16, o[4 * g + 2] * sc16, o[4 * g + 3] * sc16); }
                    asm volatile("" ::: "memory");
                    if ((c16 >> 2) == ps) {
#pragma unroll
                        for (int it = 0; it < 8; ++it) ot[it] = *(const LAS u32x4*)(stg + (4 * it + rs) * 80 + 16 * (c16 & 3));
                    }
                    asm volatile("" ::: "memory");
                }
#pragma unroll
                for (int it = 0; it < 8; ++it) *(u32x4*)(o8 + (row0 + 4 * it + rs) * DM + h * 256 + 16 * c16) = ot[it];
            }
        }
    }
    asm volatile("s_waitcnt vmcnt(0)" ::: "memory");
    __syncthreads();
#undef A8_QROWS
}

DI void p7_router(Frame& F, const Args& a) {
    const lptr L = F.lds; const int w = F.wave;
    constexpr int RW_STRIDE = 2064, RW_HALF = 37 * RW_STRIDE, RW_HIST = 2 * RW_HALF;
    LAS unsigned* hist = (LAS unsigned*)(L + RW_HIST); LAS unsigned* base = hist + 32;
    const bf16_t* x2 = (const bf16_t*)(F.ws + WS_X2B); const bf16_t* whi = (const bf16_t*)(F.ws + WS_WR); const bf16_t* wlo = whi + 48 * 1024;
    {
        const int t0 = F.wave * 64 + lane_id();
        for (int i = t0; i < 37 * 128; i += NTHR) { const int r = i >> 7, c = i & 127; const int srow = r < 32 ? r : (r < 36 ? 32 + 4 * (r - 32) : -1);
            u32x4 vh = {0u, 0u, 0u, 0u}, vl = {0u, 0u, 0u, 0u};
            if (srow >= 0) { vh = *(const u32x4*)(whi + (size_t)srow * 1024 + c * 8); vl = *(const u32x4*)(wlo + (size_t)srow * 1024 + c * 8); }
            *(LAS u32x4*)(L + r * RW_STRIDE + c * 16) = vh; *(LAS u32x4*)(L + RW_HALF + r * RW_STRIDE + c * 16) = vl; }
        __syncthreads();
    }
    unsigned* gcnt = (unsigned*)(F.ws + WS_CTL) + CW_CNT;
    int* rowid = (int*)(F.ws + WS_ROWID); f32x2* rowf = (f32x2*)(F.ws + WS_ROWF);
    const float* b_group = a.in[17]; const float* b_router = a.in[19];
    for (int blk = F.vcu; blk < NT / 256; blk += F.G) {
        int tid = F.wave * 64 + lane_id(); asm volatile("" : "+v"(tid));
        const int lane = tid & 63, fr = lane & 15, fq = lane >> 4;
        if (tid < 32) hist[tid] = 0u;
        __syncthreads();
        const size_t tok0 = (size_t)blk * 256 + 32 * w;
        f32x4 acc[2][3]; float ssq[2] = {0.f, 0.f};
#pragma unroll
        for (int rg = 0; rg < 2; ++rg)
#pragma unroll
            for (int cb = 0; cb < 3; ++cb) acc[rg][cb] = (f32x4){0.f, 0.f, 0.f, 0.f};
#pragma unroll 4
        for (int ks = 0; ks < 32; ++ks) {
            bf16x8 xf[2];
#pragma unroll
            for (int rg = 0; rg < 2; ++rg) { xf[rg] = *(const bf16x8*)(x2 + (tok0 + 16 * rg + fr) * DM + 32 * ks + 8 * fq); const u32x4 xu = __builtin_bit_cast(u32x4, xf[rg]);
                const float e0 = bflo(xu.x), e1 = bfhi(xu.x), e2 = bflo(xu.y), e3 = bfhi(xu.y), e4 = bflo(xu.z), e5 = bfhi(xu.z), e6 = bflo(xu.w), e7 = bfhi(xu.w);
                ssq[rg] += (e0 * e0 + e1 * e1) + (e2 * e2 + e3 * e3) + (e4 * e4 + e5 * e5) + (e6 * e6 + e7 * e7); }
#pragma unroll
            for (int cb = 0; cb < 3; ++cb) { const int lrow = cb < 2 ? 16 * cb + fr : ((fr & 3) == 0 ? 32 + (fr >> 2) : 36); const lptr wp = L + lrow * RW_STRIDE + (32 * ks + 8 * fq) * 2; const bf16x8 wh = lds16(wp), wl = lds16(wp + RW_HALF);
#pragma unroll
                for (int rg = 0; rg < 2; ++rg) { acc[rg][cb] = mfma16(wh, xf[rg], acc[rg][cb]); acc[rg][cb] = mfma16(wl, xf[rg], acc[rg][cb]); } }
        }
        int e1_[2], e2_[2]; unsigned r1_[2], r2_[2]; float w1_[2], w2_[2], rs_[2]; bool win_[2];
#pragma unroll
        for (int rg = 0; rg < 2; ++rg) {
            float sq = ssq[rg]; sq += __shfl_xor(sq, 16); sq += __shfl_xor(sq, 32);
            const float rstd = rsqrtf(sq * (1.f / DM) + EPS);
            float l[8];
#pragma unroll
            for (int i = 0; i < 4; ++i) { l[i] = acc[rg][0][i] * rstd + b_router[8 * fq + i]; l[4 + i] = acc[rg][1][i] * rstd + b_router[8 * fq + 4 + i]; }
            const float gl = acc[rg][2][0] * rstd + b_group[fq];
            const float g0 = __shfl(gl, fr), g1 = __shfl(gl, fr + 16), g2 = __shfl(gl, fr + 32), g3 = __shfl(gl, fr + 48);
            int gsel = 0; float gmax = g0;
            if (g1 > gmax) { gmax = g1; gsel = 1; } if (g2 > gmax) { gmax = g2; gsel = 2; } if (g3 > gmax) { gmax = g3; gsel = 3; }
            const float gw = 1.f / (__expf(g0 - gmax) + __expf(g1 - gmax) + __expf(g2 - gmax) + __expf(g3 - gmax));
            int i1 = 0; float m1 = l[0];
#pragma unroll
            for (int i = 1; i < 8; ++i) if (l[i] > m1) { m1 = l[i]; i1 = i; }
            int i2 = -1; float m2 = -INFINITY;
#pragma unroll
            for (int i = 0; i < 8; ++i) if (i != i1 && l[i] > m2) { m2 = l[i]; i2 = i; }
            const float p2 = __expf(m2 - m1);
            win_[rg] = (fq == gsel); e1_[rg] = 8 * fq + i1; e2_[rg] = 8 * fq + i2; w1_[rg] = gw / (1.f + p2); w2_[rg] = gw * p2 / (1.f + p2); rs_[rg] = rstd;
            r1_[rg] = 0u; r2_[rg] = 0u;
            if (win_[rg]) { r1_[rg] = atomicAdd((unsigned*)&hist[e1_[rg]], 1u); r2_[rg] = atomicAdd((unsigned*)&hist[e2_[rg]], 1u); }
        }
        __syncthreads();
        if (tid < 32) base[tid] = atomicAdd(&gcnt[tid], hist[tid]);
        __syncthreads();
#pragma unroll
        for (int rg = 0; rg < 2; ++rg) if (win_[rg]) {
            const int tok = (int)tok0 + 16 * rg + fr;
            const size_t s1 = (size_t)e1_[rg] * CAPE + base[e1_[rg]] + r1_[rg], s2 = (size_t)e2_[rg] * CAPE + base[e2_[rg]] + r2_[rg];
            rowid[s1] = 2 * tok; rowf[s1] = (f32x2){rs_[rg], w1_[rg]}; rowid[s2] = 2 * tok + 1; rowf[s2] = (f32x2){rs_[rg], w2_[rg]};
        }
        __syncthreads();
    }
}
DI void moe_setup(Frame& F) {
    LAS int* tb = (LAS int*)(F.lds + MISC_OFF); LAS int* cn = tb + 40;
    const unsigned* gcnt = (const unsigned*)(F.ws + WS_CTL) + CW_CNT;
    const int tid = F.wave * 64 + lane_id();
    __syncthreads();
    if (tid < 32) cn[tid] = (int)__hip_atomic_load(gcnt + tid, __ATOMIC_RELAXED, __HIP_MEMORY_SCOPE_AGENT);
    __syncthreads();
    if (tid == 0) { int acc = 0; for (int e = 0; e < 32; ++e) { tb[e] = acc; acc += (cn[e] + 255) >> 8; } tb[32] = acc; }
    __syncthreads();
}
struct SchedMoE {
    LAS const int* tb; LAS const int* cn; int G, vcu, K, gather; const char* A; const char* Bbase; size_t b_estride, b_tstride; const int* rowid;
    DI bool next(int i, pg8::Unit& u) const {
        const int L = i * G + vcu; if (L >= tb[32] * 4) return false;
        const int t = L >> 2, pn = L & 3; int e = 0;
#pragma unroll
        for (int j = 1; j < 32; ++j) e += (tb[j] <= t) ? 1 : 0;
        u.pm = t; u.pn = pn; u.tag = e; u.aux = t - tb[e];
        u.B = Bbase + (size_t)e * b_estride + (size_t)pn * b_tstride;
        u.A = gather ? A : A + (size_t)t * 256 * K;
        return true;
    }
    DI unsigned arow(const pg8::Unit& u, int row) const { const int slot = u.aux * 256 + row; return slot < cn[u.tag] ? (unsigned)(rowid[(size_t)u.tag * CAPE + slot] >> 1) : 0u; }
    DI const int* arow_ptr(const pg8::Unit& u, int row) const { return rowid + ((size_t)u.tag * CAPE + u.aux * 256 + row); }
    DI int rows_left(const pg8::Unit& u) const { return cn[u.tag] - u.aux * 256; }
};
struct EpiM1 {
    const f32x2* rowf; bf16_t* hid;
    static constexpr int NPRE = 8;
    DI void prefetch(unsigned (&pre)[8], const pg8::Unit& u, int wr, int fr) const {
        asm volatile("" : "+v"(fr));
#pragma unroll
        for (int ai = 0; ai < 2; ++ai)
#pragma unroll
            for (int m = 0; m < 4; ++m) asm volatile("global_load_dword %0, %1, off" : "=v"(pre[ai * 4 + m]) : "v"((const float*)(rowf + ((size_t)u.tag * CAPE + u.aux * 256 + ai * 128 + wr * 64 + m * 16 + fr))) : "memory");
    }
    DI void operator()(const f32x4 (&acc)[2][2][4][2], const pg8::Unit& u, int wr, int wc, int fr, int fq, const unsigned (&pre)[8]) const {
        asm volatile("" : "+v"(fr), "+v"(fq));
        float rs[2][4];
#pragma unroll
        for (int ai = 0; ai < 2; ++ai)
#pragma unroll
            for (int m = 0; m < 4; ++m) rs[ai][m] = __uint_as_float(pre[ai * 4 + m]);
        const int odd = fq & 1;
#pragma unroll
        for (int ai = 0; ai < 2; ++ai) {
            u32x2 wh[4];
#pragma unroll
            for (int m = 0; m < 4; ++m) { const float rstd = rs[ai][m];
                const f32x4 g0 = acc[ai][0][m][0] * rstd, g1 = acc[ai][0][m][1] * rstd, u0 = acc[ai][1][m][0] * rstd, u1 = acc[ai][1][m][1] * rstd;
                wh[m].x = pk4_fp8(silu_f(g0[0]) * u0[0], silu_f(g0[1]) * u0[1], silu_f(g0[2]) * u0[2], silu_f(g0[3]) * u0[3]);
                wh[m].y = pk4_fp8(silu_f(g1[0]) * u1[0], silu_f(g1[1]) * u1[1], silu_f(g1[2]) * u1[2], silu_f(g1[3]) * u1[3]); }
#pragma unroll
            for (int mp = 0; mp < 2; ++mp) { const int row = ai * 128 + wr * 64 + (2 * mp + odd) * 16 + fr;
                *(u32x4*)((unsigned char*)hid + ((size_t)u.pm * 256 + row) * DEXP + u.pn * 128 + wc * 32 + 8 * (fq - odd)) = pair16(wh[2 * mp], wh[2 * mp + 1]); }
        }
    }
};
struct EpiM2 {
    LAS const int* cn; const int* rowid; const f32x2* rowf; bf16_t* ybuf;
    static constexpr int NPRE = 16;
    DI void prefetch(unsigned (&pre)[16], const pg8::Unit& u, int wr, int fr) const {
        asm volatile("" : "+v"(fr));
#pragma unroll
        for (int ai = 0; ai < 2; ++ai)
#pragma unroll
            for (int m = 0; m < 4; ++m) { const size_t si = (size_t)u.tag * CAPE + u.aux * 256 + ai * 128 + wr * 64 + m * 16 + fr;
                asm volatile("global_load_dword %0, %1, off" : "=v"(pre[ai * 4 + m]) : "v"(rowid + si) : "memory");
                asm volatile("global_load_dword %0, %1, off" : "=v"(pre[8 + ai * 4 + m]) : "v"((const float*)(rowf + si) + 1) : "memory"); }
    }
    DI void operator()(const f32x4 (&acc)[2][2][4][2], const pg8::Unit& u, int wr, int wc, int fr, int fq, const unsigned (&pre)[16]) const {
        asm volatile("" : "+v"(fr), "+v"(fq));
        int ids[2][4]; float wgs[2][4];
#pragma unroll
        for (int ai = 0; ai < 2; ++ai)
#pragma unroll
            for (int m = 0; m < 4; ++m) { ids[ai][m] = (int)pre[ai * 4 + m]; wgs[ai][m] = __uint_as_float(pre[8 + ai * 4 + m]); }
        const int cnt = cn[u.tag];
#pragma unroll
        for (int ai = 0; ai < 2; ++ai)
#pragma unroll
            for (int mp = 0; mp < 2; ++mp) {
                const int odd = fq & 1, mm = 2 * mp + odd;
                const int row = ai * 128 + wr * 64 + mm * 16 + fr, slot = u.aux * 256 + row;
                const int idA = ids[ai][2 * mp], idB = ids[ai][2 * mp + 1]; const int id = idA ^ ((idA ^ idB) & -odd);
                const float wa = wgs[ai][2 * mp] * 16.f, wb = wgs[ai][2 * mp + 1] * 16.f;
#pragma unroll
                for (int bj = 0; bj < 2; ++bj) { const f32x4 a0 = acc[ai][bj][2 * mp][0] * wa, a1 = acc[ai][bj][2 * mp][1] * wa, b0 = acc[ai][bj][2 * mp + 1][0] * wb, b1 = acc[ai][bj][2 * mp + 1][1] * wb;
                    u32x2 wA, wB; wA.x = pk4_fp8(a0[0], a0[1], a0[2], a0[3]); wA.y = pk4_fp8(a1[0], a1[1], a1[2], a1[3]); wB.x = pk4_fp8(b0[0], b0[1], b0[2], b0[3]); wB.y = pk4_fp8(b1[0], b1[1], b1[2], b1[3]);
                    const u32x4 v = pair16(wA, wB);
                    if (slot < cnt) *(u32x4*)((unsigned char*)ybuf + (size_t)id * DM + u.pn * 256 + bj * 128 + wc * 32 + 8 * (fq - odd)) = v; }
            }
    }
};

DI void p_final(Frame& F, const Args& a, size_t src_off) {
    const int gw = F.vcu * NWAVES + F.wave, NGW = F.G * NWAVES, lane = lane_id_v();
    const bf16_t* x2 = (const bf16_t*)(F.ws + src_off); const unsigned char* yb = F.ws + WS_YBUF;
    const float* g = a.in[23];
    f32x4 gv[4];
#pragma unroll
    for (int j = 0; j < 4; ++j) gv[j] = *((const f32x4*)g + lane * 2 + (j & 1) + 128 * (j >> 1));
    u32x4 xaA[2], xaB[2], xaC[2]; u32x2 y0A[2], y0B[2], y0C[2], y1A[2], y1B[2], y1C[2];
#define PF_LOAD(S, row_) do { const int r_ = (row_) < NT ? (row_) : gw; _Pragma("unroll") for (int hlf = 0; hlf < 2; ++hlf) { \
        asm volatile("global_load_dwordx4 %0, %1, off" : "=v"(xa##S[hlf]) : "v"((const u32x4*)(x2 + (size_t)r_ * DM) + lane + 64 * hlf) : "memory"); \
        asm volatile("global_load_dwordx2 %0, %1, off" : "=v"(y0##S[hlf]) : "v"((const u32x2*)(yb + (size_t)(2 * r_) * DM) + lane + 64 * hlf) : "memory"); \
        asm volatile("global_load_dwordx2 %0, %1, off" : "=v"(y1##S[hlf]) : "v"((const u32x2*)(yb + (size_t)(2 * r_ + 1) * DM) + lane + 64 * hlf) : "memory"); } } while (0)
#define PF_WAIT(n_, S) asm volatile("s_waitcnt vmcnt(" #n_ ")" : "+v"(xa##S[0]), "+v"(xa##S[1]), "+v"(y0##S[0]), "+v"(y0##S[1]), "+v"(y1##S[0]), "+v"(y1##S[1]) :: "memory")
#define PF_Y8(q, W, HI) { const f32x2 f0 = __builtin_amdgcn_cvt_pk_f32_fp8((int)a0.W, HI), f1 = __builtin_amdgcn_cvt_pk_f32_fp8((int)a1.W, HI); \
        t[2 * q] += (f0[0] + f1[0]) * 0.0625f; t[2 * q + 1] += (f0[1] + f1[1]) * 0.0625f; }
#define PF_DO(S, row_) do { const int ro_ = (row_) < NT ? (row_) : gw; float v[16]; \
        _Pragma("unroll") for (int hlf = 0; hlf < 2; ++hlf) { const u32x4 xv = xa##S[hlf]; \
            float t[8] = {bflo(xv.x), bfhi(xv.x), bflo(xv.y), bfhi(xv.y), bflo(xv.z), bfhi(xv.z), bflo(xv.w), bfhi(xv.w)}; \
            { const u32x2 a0 = y0##S[hlf], a1 = y1##S[hlf]; PF_Y8(0, x, false) PF_Y8(1, x, true) PF_Y8(2, y, false) PF_Y8(3, y, true) } \
            _Pragma("unroll") for (int j = 0; j < 8; ++j) v[8 * hlf + j] = t[j]; } \
        float s = 0.f; _Pragma("unroll") for (int j = 0; j < 16; ++j) s += v[j] * v[j]; \
        const float rstd = rsqrtf(wave_sum(s) * (1.f / DM) + EPS); \
        f32x4* o = (f32x4*)(a.out + (size_t)ro_ * DM); \
        _Pragma("unroll") for (int j = 0; j < 4; ++j) { f32x4 r; r.x = v[4 * j] * rstd * gv[j].x; r.y = v[4 * j + 1] * rstd * gv[j].y; r.z = v[4 * j + 2] * rstd * gv[j].z; r.w = v[4 * j + 3] * rstd * gv[j].w; \
            o[lane * 2 + (j & 1) + 128 * (j >> 1)] = r; } } while (0)
    PF_LOAD(A, gw); PF_LOAD(B, gw + NGW); PF_LOAD(C, gw + 2 * NGW);
    PF_WAIT(12, A); PF_DO(A, gw); PF_LOAD(A, gw + 3 * NGW);
    PF_WAIT(16, B); PF_DO(B, gw + NGW); PF_LOAD(B, gw + 4 * NGW);
    for (int m = gw + 2 * NGW; m < NT; m += 3 * NGW) {
        PF_WAIT(20, C); PF_DO(C, m); PF_LOAD(C, m + 3 * NGW);
        PF_WAIT(20, A); PF_DO(A, m + NGW); PF_LOAD(A, m + 4 * NGW);
        PF_WAIT(20, B); PF_DO(B, m + 2 * NGW); PF_LOAD(B, m + 5 * NGW);
    }
#undef PF_LOAD
#undef PF_WAIT
#undef PF_Y8
#undef PF_DO
}

__global__ void __launch_bounds__(NTHR, 2) fwd_megakernel(Args args) {
    extern __shared__ __attribute__((aligned(16))) unsigned char lds_raw[];
    Frame F;
    F.lds = (lptr)lds_raw; F.wave = __builtin_amdgcn_readfirstlane((int)threadIdx.x >> 6);
    F.G = gridDim.x; F.bx = blockIdx.x; F.vcu = (F.G % 8 == 0) ? (F.bx % 8) * (F.G / 8) + F.bx / 8 : F.bx;
    F.ws = args.ws;
    const int lo = args.ph_lo, hi = args.ph_hi;
    const bool leader = (F.wave == 0) && (lane_id() == 0);
    { volatile LAS unsigned* st = (volatile LAS unsigned*)(F.lds + MISC_OFF + 768); if (leader) { st[0] = 0u; st[1] = 0u; } }
    __syncthreads();
    const XcdBarrier gbar = xcd_barrier_post((unsigned*)(F.ws + WS_CTL) + CW_BAR, (volatile LAS unsigned*)(F.lds + MISC_OFF + 768), leader);
#define IN(k) (lo <= (k) && (k) < hi)
#define SEAM(k) do { if (IN(k) && hi > (k) + 1) xcd_barrier(gbar, (F.wave == 0) && (lane_id() == 0)); } while (0)
    if (IN(0)) { p0_prologue(F, args); __syncthreads(); moe_weight_items(F, args, F.vcu * NWAVES + F.wave, F.G * NWAVES, MW_SPLIT, 3 * 32 * 16 * 16); }
    SEAM(0);
    if (IN(1)) {
        SchedDense S; S.o.init(NT, NP1, F.G, F.bx); S.A = (const char*)(F.ws + WS_XN0); S.B = (const char*)(F.ws + WS_WIN); S.K = DM;
        EpiP1 E{(bf16_t*)(F.ws + WS_PROJ), (bf16_t*)(F.ws + WS_KV), (const f32x4*)(F.ws + WS_ROPE)};
        pg8::gemm_phase<EpiP1, SchedDense, false>(F.lds, 2 * DM, S, E, F.wave);
    }
    SEAM(1);
    if (IN(2)) { p2_mixer(F, args); }
    SEAM(2);
    if (IN(3)) {
        SchedDense S; S.o.init(NT, DM, F.G, F.bx); S.A = (const char*)(F.ws + WS_MIX); S.B = (const char*)(F.ws + WS_WOUT); S.K = DM;
        EpiP3 E{(const bf16_t*)(F.ws + WS_XN0), (const float*)(F.ws + WS_RMS), (bf16_t*)(F.ws + WS_X1B), (float*)(F.ws + WS_SSQ1), F.ws + WS_X1Q8};
        pg8::gemm_phase<EpiP3, SchedDense, false>(F.lds, 2 * DM, S, E, F.wave);
    }
    SEAM(3);
    if (IN(4)) {
        SchedQ S; S.G = F.G; S.vcu = F.vcu; S.A = (const char*)(F.ws + WS_X1Q8); S.B = (const char*)(F.ws + WS_WQ); S.K = DM / 2;
        EpiP4 E{(const float*)(F.ws + WS_SSQ1), F.ws + WS_Q};
        pg8::gemm_phase<EpiP4, SchedQ, false, true>(F.lds, DM, S, E, F.wave, 124);
    }
    if (IN(4) != IN(5)) xcd_barrier(gbar, (F.wave == 0) && (lane_id() == 0));
    if (IN(5)) { attn8_phase(F); }
    SEAM(5);
    if (IN(6)) {
        SchedDense S; S.o.init(NT, DM, F.G, F.bx); S.A = (const char*)(F.ws + WS_O); S.B = (const char*)(F.ws + WS_WO); S.K = DM / 2;
        EpiP6 E{(const bf16_t*)(F.ws + WS_X1B), (bf16_t*)(F.ws + WS_X2B), F.ws + WS_XQ8};
        pg8::gemm_phase<EpiP6, SchedDense, false, true>(F.lds, DM, S, E, F.wave, 122, 123);
    }
    SEAM(6);
    if (IN(7)) { p7_router(F, args); }
    SEAM(7);
    if (IN(8)) {
        moe_setup(F);
        SchedMoE S; S.tb = (LAS const int*)(F.lds + MISC_OFF); S.cn = S.tb + 40; S.G = F.G; S.vcu = F.vcu; S.K = DM; S.gather = 1;
        S.A = (const char*)(F.ws + WS_XQ8); S.Bbase = (const char*)(F.ws + WS_W1); S.b_estride = (size_t)1024 * DM; S.b_tstride = (size_t)256 * DM; S.rowid = (const int*)(F.ws + WS_ROWID);
        EpiM1 E{(const f32x2*)(F.ws + WS_ROWF), (bf16_t*)(F.ws + WS_HID)};
        pg8::gemm_phase<EpiM1, SchedMoE, true, true>(F.lds, DM, S, E, F.wave, 122);
    }
    SEAM(8);
    if (IN(9)) {
        moe_setup(F);
        SchedMoE S; S.tb = (LAS const int*)(F.lds + MISC_OFF); S.cn = S.tb + 40; S.G = F.G; S.vcu = F.vcu; S.K = DEXP; S.gather = 0;
        S.A = (const char*)(F.ws + WS_HID); S.Bbase = (const char*)(F.ws + WS_W2); S.b_estride = (size_t)DM * DEXP; S.b_tstride = (size_t)256 * DEXP; S.rowid = (const int*)(F.ws + WS_ROWID);
        EpiM2 E{S.cn, (const int*)(F.ws + WS_ROWID), (const f32x2*)(F.ws + WS_ROWF), (bf16_t*)(F.ws + WS_YBUF)};
        pg8::gemm_phase<EpiM2, SchedMoE, false, true>(F.lds, DEXP, S, E, F.wave, 123);
    }
    SEAM(9);
    if (IN(10)) { p_final(F, args, WS_X2B); }
#undef IN
#undef SEAM
}


#if DUPK == 55
__global__ void __launch_bounds__(NTHR, 2) attn_probe_kernel(Args args) {
    extern __shared__ __attribute__((aligned(16))) unsigned char lds_raw[];
    Frame F;
    F.lds = (lptr)lds_raw; F.wave = __builtin_amdgcn_readfirstlane((int)threadIdx.x >> 6);
    F.G = gridDim.x; F.bx = blockIdx.x; F.vcu = (F.G % 8 == 0) ? (F.bx % 8) * (F.G / 8) + F.bx / 8 : F.bx;
    F.ws = args.ws;
    attn_phase<DBGV>(F);
}
#endif
extern "C" void kernel_launch(void* const* d_in, const int* in_sizes, int n_in, void* d_out, int out_size, void* d_ws, size_t ws_size, hipStream_t stream) {
    static int grid = 0;
    if (grid == 0) {
        if (n_in != 24 || out_size != NT * DM || ws_size < WS_END) { fprintf(stderr, "kernel_launch: unexpected shapes (n_in %d out %d ws %zu)\n", n_in, out_size, ws_size); grid = -1; return; }
        int dev = 0, cus = 0, per_cu = 0;
        hipGetDevice(&dev); hipDeviceGetAttribute(&cus, hipDeviceAttributeMultiprocessorCount, dev);
        hipFuncSetAttribute((const void*)fwd_megakernel, hipFuncAttributeMaxDynamicSharedMemorySize, LDS_BYTES);
        hipOccupancyMaxActiveBlocksPerMultiprocessor(&per_cu, (const void*)fwd_megakernel, NTHR, LDS_BYTES);
        if (per_cu < 1) { fprintf(stderr, "kernel_launch: occupancy query says %d blocks/CU\n", per_cu); per_cu = 1; }
        (void)hipGetLastError();
        grid = cus * 1;
        if (grid > 256) grid = 256;
    }
    if (grid < 0) return;
    hipMemsetAsync((char*)d_ws + WS_CTL, 0, CTL_ZERO_BYTES, stream);
    Args a{};
    for (int i = 0; i < 24; ++i) a.in[i] = (const float*)d_in[i];
    a.out = (float*)d_out; a.ws = (unsigned char*)d_ws; a.ph_lo = 0; a.ph_hi = 11; a.dupk = DUPK; a.dbg = 0;
    void* kargs[] = {&a};
    hipError_t e = hipLaunchCooperativeKernel((const void*)fwd_megakernel, dim3(grid), dim3(NTHR), kargs, LDS_BYTES, stream);
    if (e != hipSuccess) fprintf(stderr, "cooperative launch failed: %s (grid %d)\n", hipGetErrorString(e), grid);
#if DUPK == 55
    { static bool once = false; if (!once) { hipFuncSetAttribute((const void*)attn_probe_kernel, hipFuncAttributeMaxDynamicSharedMemorySize, LDS_BYTES); once = true; }
      void* pa[] = {&a}; hipLaunchCooperativeKernel((const void*)attn_probe_kernel, dim3(grid), dim3(NTHR), pa, LDS_BYTES, stream); }
#elif DUPK >= 0
    hipMemsetAsync((char*)d_ws + WS_CTL + 4096 * 4, 0, 16384, stream);
    a.ph_lo = DUPK; a.ph_hi = DUPK + 1; a.dbg = DBGV;
    e = hipLaunchCooperativeKernel((const void*)fwd_megakernel, dim3(grid), dim3(NTHR), kargs, LDS_BYTES, stream);
#endif
}
```
